# Optimizing an MI355X kernel written in HIP

```python
import math
import jax, jax.numpy as jnp
from jax import lax
import numpy as np

D_MODEL = 1024
BATCH = 16
SEQ = 4096
DEPTH = 4

D_MIX = D_MODEL
ATT_HEADS = 8
ATT_HEAD_DIM = 64
ATT_WIDTH = ATT_HEADS * ATT_HEAD_DIM
KV_LATENT = 128
IDX_HEADS = 8
IDX_DIM = 32
TOPK_MAX = 256
Q_BLOCK = 128
SSM_WIDTH = D_MIX - ATT_WIDTH
GROUP_CH = 16
N_GROUPS = SSM_WIDTH // GROUP_CH
STATE = 64
DT_MIN = 0.001
DT_MAX = 0.1
LN_EPS = 1e-5
RMS_EPS = 1e-6
DEEPNORM_ALPHA = (2 * DEPTH) ** 0.25
DEEPNORM_BETA = (8 * DEPTH) ** -0.25
SPLITS = (ATT_WIDTH, KV_LATENT, IDX_HEADS * IDX_DIM, IDX_DIM, IDX_HEADS, ATT_WIDTH, SSM_WIDTH, SSM_WIDTH)
D_IN = sum(SPLITS)

kernel_name = 'hymba_dsa_s5_deepnorm_trunk'


def _split_points():
    pts, acc = [], 0
    for s in SPLITS[:-1]:
        acc += s
        pts.append(acc)
    return pts


def layer_norm(x, g, b):
    xf = x.astype(jnp.float32)
    mu = jnp.mean(xf, axis=-1, keepdims=True)
    var = jnp.mean(jnp.square(xf - mu), axis=-1, keepdims=True)
    y = (xf - mu) * lax.rsqrt(var + LN_EPS) * g.astype(jnp.float32) + b.astype(jnp.float32)
    return y.astype(x.dtype)


def rms_norm(x, g):
    xf = x.astype(jnp.float32)
    y = xf * lax.rsqrt(jnp.mean(jnp.square(xf), axis=-1, keepdims=True) + RMS_EPS)
    return y * g.astype(jnp.float32)


def dsa_attention(q, c_kv, q_idx, k_idx, w_idx, kv_g, w_uk, w_uv):
    bsz, seq, _ = q.shape
    n_sel = min(TOPK_MAX, seq // 4)
    n_blk = seq // Q_BLOCK
    c = rms_norm(c_kv, kv_g)
    qh = q.reshape(bsz, seq, ATT_HEADS, ATT_HEAD_DIM)
    q_lat = jnp.einsum('bshd,hcd->bshc', qh, w_uk).astype(jnp.float32) * (ATT_HEAD_DIM ** -0.5)
    qi = q_idx.reshape(bsz, seq, IDX_HEADS, IDX_DIM).astype(jnp.float32) * (IDX_DIM ** -0.5)
    ki = k_idx.astype(jnp.float32)
    wi = w_idx.astype(jnp.float32) * (IDX_HEADS ** -0.5)
    key_pos = jnp.arange(seq, dtype=jnp.int32)
    neg = jnp.finfo(jnp.float32).min

    def to_blocks(a):
        return jnp.moveaxis(a.reshape(bsz, n_blk, Q_BLOCK, *a.shape[2:]), 1, 0)

    def block(args):
        blk, ql_b, qi_b, wi_b = args
        q_pos = blk * Q_BLOCK + jnp.arange(Q_BLOCK, dtype=jnp.int32)
        causal = key_pos[None, :] <= q_pos[:, None]
        idx_logits = jnp.einsum('bthd,bsd->bths', qi_b, ki)
        index_score = jnp.einsum('bths,bth->bts', jax.nn.relu(idx_logits), wi_b)
        index_score = jnp.where(causal[None], index_score, neg)
        _, sel = lax.top_k(index_score, n_sel)
        valid = sel <= q_pos[None, :, None]
        c_sel = jax.vmap(lambda cb, ib: cb[ib])(c, sel)
        s = jnp.einsum('bthc,btkc->bthk', ql_b, c_sel)
        s = jnp.where(valid[:, :, None, :], s, neg)
        p = jax.nn.softmax(s, axis=-1)
        return jnp.einsum('bthk,btkc->bthc', p, c_sel)

    o_lat = lax.map(block, (jnp.arange(n_blk, dtype=jnp.int32), to_blocks(q_lat), to_blocks(qi), to_blocks(wi)))
    o_lat = jnp.moveaxis(o_lat, 0, 1).reshape(bsz, seq, ATT_HEADS, KV_LATENT)
    out = jnp.einsum('bshc,hcd->bshd', o_lat.astype(w_uv.dtype), w_uv)
    return out.reshape(bsz, seq, ATT_WIDTH).astype(q.dtype)


def _ssm_combine(e_i, e_j):
    a_i, b_i = e_i
    a_j, b_j = e_j
    return a_j * a_i, a_j * b_i + b_j


def s5_branch(u, log_dt, a_re, a_im, b_re, b_im, c_re, c_im, d_skip, w_glu, b_glu):
    bsz, seq, _ = u.shape
    f32 = jnp.float32
    u32 = u.astype(f32).reshape(bsz, seq, N_GROUPS, GROUP_CH)
    lam = lax.complex(a_re.astype(f32), a_im.astype(f32))
    dt = jnp.exp(log_dt.astype(f32))[:, None]
    a_bar = jnp.exp(lam * dt)
    b_bar = ((a_bar - 1.0) / lam)[..., None] * lax.complex(b_re.astype(f32), b_im.astype(f32))
    c_mat = lax.complex(c_re.astype(f32), c_im.astype(f32))
    bu = jnp.einsum('bsgc,gpc->bsgp', u32.astype(jnp.complex64), b_bar)
    a_seq = jnp.broadcast_to(a_bar[None, None], (1, seq, N_GROUPS, STATE))
    _, states = lax.associative_scan(_ssm_combine, (a_seq, bu), axis=1)
    y = jnp.einsum('bsgp,gcp->bsgc', states, c_mat).real + d_skip.astype(f32) * u32
    y = jax.nn.gelu(y.reshape(bsz, seq, SSM_WIDTH))
    h = jnp.einsum('bsc,ce->bse', y, w_glu.astype(f32)) + b_glu.astype(f32)
    val, gate = jnp.split(h, 2, axis=-1)
    return (val * jax.nn.sigmoid(gate)).astype(u.dtype)


def hybrid_layer(x, w_in, kv_g, w_uk, w_uv, log_dt, a_re, a_im, b_re, b_im, c_re, c_im, d_skip, w_glu, b_glu, w_out, ln_g, ln_b):
    proj = jnp.einsum('bsd,de->bse', x, w_in)
    q, c_kv, q_idx, k_idx, w_idx, gate_a, u, gate_s = jnp.split(proj, _split_points(), axis=-1)
    att = dsa_attention(q, c_kv, q_idx, k_idx, w_idx, kv_g, w_uk, w_uv)
    ssm = s5_branch(u, log_dt, a_re, a_im, b_re, b_im, c_re, c_im, d_skip, w_glu, b_glu)
    mixed = jnp.concatenate([att * jax.nn.silu(gate_a), ssm * jax.nn.silu(gate_s)], axis=-1)
    y = jnp.einsum('bse,ed->bsd', mixed, w_out)
    return layer_norm(DEEPNORM_ALPHA * x + y, ln_g, ln_b)


def setup_inputs(seed: int = 0) -> dict:
    key = jax.random.key(seed)
    ks = jax.random.split(key, 19)
    f = jnp.float32
    L = DEPTH
    nrm = jax.random.normal
    x = nrm(ks[0], (BATCH, SEQ, D_MODEL), f)
    w_in = nrm(ks[1], (L, D_MODEL, D_IN), f) * (D_MODEL ** -0.5)
    kv_norm_g = 1.0 + 0.1 * nrm(ks[2], (L, KV_LATENT), f)
    w_uk = nrm(ks[3], (L, ATT_HEADS, KV_LATENT, ATT_HEAD_DIM), f) * (KV_LATENT ** -0.5)
    w_uv = nrm(ks[4], (L, ATT_HEADS, KV_LATENT, ATT_HEAD_DIM), f) * (KV_LATENT ** -0.5) * DEEPNORM_BETA
    log_dt = jax.random.uniform(ks[5], (L, N_GROUPS), f, minval=math.log(DT_MIN), maxval=math.log(DT_MAX))
    n = jnp.arange(STATE, dtype=f)
    a_re = -0.5 + 0.01 * nrm(ks[6], (L, N_GROUPS, STATE), f)
    a_im = jnp.pi * n + 0.01 * nrm(ks[7], (L, N_GROUPS, STATE), f)
    b_re = nrm(ks[8], (L, N_GROUPS, STATE, GROUP_CH), f) * ((2 * GROUP_CH) ** -0.5)
    b_im = nrm(ks[9], (L, N_GROUPS, STATE, GROUP_CH), f) * ((2 * GROUP_CH) ** -0.5)
    c_re = nrm(ks[10], (L, N_GROUPS, GROUP_CH, STATE), f) * ((2 * STATE) ** -0.5)
    c_im = nrm(ks[11], (L, N_GROUPS, GROUP_CH, STATE), f) * ((2 * STATE) ** -0.5)
    d_skip = nrm(ks[12], (L, N_GROUPS, GROUP_CH), f)
    w_glu = nrm(ks[13], (L, SSM_WIDTH, 2 * SSM_WIDTH), f) * (SSM_WIDTH ** -0.5)
    b_glu = 0.01 * nrm(ks[14], (L, 2 * SSM_WIDTH), f)
    w_out = nrm(ks[15], (L, D_MIX, D_MODEL), f) * (D_MIX ** -0.5) * DEEPNORM_BETA
    ln_g = 1.0 + 0.1 * nrm(ks[16], (L, D_MODEL), f)
    ln_b = 0.01 * nrm(ks[17], (L, D_MODEL), f)
    return {'x': x, 'w_in': w_in, 'kv_norm_g': kv_norm_g, 'w_uk': w_uk, 'w_uv': w_uv,
            'log_dt': log_dt, 'a_re': a_re, 'a_im': a_im, 'b_re': b_re, 'b_im': b_im,
            'c_re': c_re, 'c_im': c_im, 'd_skip': d_skip, 'w_glu': w_glu, 'b_glu': b_glu,
            'w_out': w_out, 'ln_g': ln_g, 'ln_b': ln_b}


def reference(x, w_in, kv_norm_g, w_uk, w_uv, log_dt, a_re, a_im, b_re, b_im, c_re, c_im, d_skip, w_glu, b_glu, w_out, ln_g, ln_b):
    h = x
    for l in range(DEPTH):
        h = hybrid_layer(h, w_in[l], kv_norm_g[l], w_uk[l], w_uv[l], log_dt[l], a_re[l], a_im[l],
                         b_re[l], b_im[l], c_re[l], c_im[l], d_skip[l], w_glu[l], b_glu[l],
                         w_out[l], ln_g[l], ln_b[l])
    return h
```

```cpp
#include <hip/hip_runtime.h>
#include <hip/hip_bf16.h>
#include <hip/hip_cooperative_groups.h>
#include <cstdio>
namespace cg = cooperative_groups;

typedef __attribute__((ext_vector_type(8))) short bf16x8;
typedef __attribute__((ext_vector_type(4))) short s16x4;
typedef __attribute__((ext_vector_type(4))) float f32x4;
typedef __attribute__((ext_vector_type(16))) float f32x16;
typedef unsigned short u16;
typedef unsigned long long u64;

#define NTOK 65536
#define SEQL 4096
#define NBATCH 16
#define DM 1024
#define DIN 2472
#define NPAD 2560
#define DEPTH 4
#define NGRP 32
#define TCH 16
#define NCHUNK 4096
#define ALPHA 1.681792830507429f
#define SMEM_BYTES 151552
#define NTHR 512
#define NWV 8
#define REG_STRIDE 18944
#define KROW 272

#define MiB (1024ull * 1024ull)
#define OFF_XB    (0ull)
#define OFF_QB    (128 * MiB)
#define OFF_CKV   (192 * MiB)
#define OFF_CN    (224 * MiB)
#define OFF_QI    (240 * MiB)
#define OFF_KI    (272 * MiB)
#define OFF_WI    (276 * MiB)
#define OFF_SGA   (278 * MiB)
#define OFF_SGS   (342 * MiB)
#define OFF_UGM   (406 * MiB)
#define OFF_QL    (470 * MiB)
#define OFF_S     (598 * MiB)
#define OFF_STATS (662 * MiB)
#define OFF_WINT  (663 * MiB)
#define OFF_WOUTT (683 * MiB)
#define OFF_WGLUT (691 * MiB)
#define OFF_WUK   (695 * MiB)
#define OFF_WUVP  (696 * MiB)
#define OFF_OP1   (697 * MiB)
#define OFF_OP2   (705 * MiB)
#define OFF_AT    (729 * MiB)

struct Params {
  const float *x, *w_in, *kvg, *w_uk, *w_uv, *log_dt, *a_re, *a_im, *b_re, *b_im, *c_re, *c_im, *d_skip, *w_glu, *b_glu, *w_out, *ln_g, *ln_b;
  float* out;
  char* ws;
  int phase_lo, phase_hi;
};

struct Ctx { int tid, bid, G; };
#define OPAQUE_V(x) asm volatile("" : "+v"(x))
#define OPAQUE_S(x) asm volatile("" : "+s"(x))

__device__ __forceinline__ u16 f2bf(float f) {
  unsigned u = __float_as_uint(f);
  u += 0x7fffu + ((u >> 16) & 1u);
  return (u16)(u >> 16);
}
__device__ __forceinline__ float bf2f(u16 h) { return __uint_as_float(((unsigned)h) << 16); }
typedef __attribute__((ext_vector_type(2))) __bf16 bf16x2_t;
typedef __attribute__((ext_vector_type(2))) float f32x2_t;
__device__ __forceinline__ unsigned pack2(float a, float b) {
  f32x2_t v = {a, b};
  bf16x2_t r = __builtin_convertvector(v, bf16x2_t);
  return *(unsigned*)&r;
}
__device__ __forceinline__ float sigmoid_fast(float v) { return __builtin_amdgcn_rcpf(1.f + __builtin_amdgcn_exp2f(-1.4426950408889634f * v)); }
__device__ __forceinline__ float silu_f(float v) { return v * sigmoid_fast(v); }
__device__ __forceinline__ float gelu_tanh(float y) {
  float t = 0.7978845608028654f * (y + 0.044715f * y * y * y);
  return y * sigmoid_fast(2.f * t);
}

struct GemmDesc {
  const u16* A; const u16* A2; const u16* Bt;
  long a_bs, a2_bs, b_bs;
  int lda, lda2, ldb, ksplit;
  int M, N, K, nbatch;
};

#define LDT 72
#define CLD 260

__device__ __forceinline__ void run_epilogue(const Params& p, int l, int epi, int b, int row0, int col0, int tid, const float* sC, int ncols);

__device__ __forceinline__ void gemm_phase(const Ctx& cx, const GemmDesc& d, int epi, const Params& p, int l, char* smem) {
  const int tid = cx.tid, lane = tid & 63, wid = __builtin_amdgcn_readfirstlane(tid >> 6), wr = wid >> 2, wc = wid & 3;
  const int nM = d.M >> 8, nN = (d.N + 255) >> 8, nk = d.K >> 6;
  const int T = d.nbatch * nM * nN;
  const int G = cx.G, bid = cx.bid;
  int start, step, end;
  if ((G & 7) == 0) {
    int per = G >> 3, chunk = (T + 7) >> 3, xcd = bid & 7;
    start = xcd * chunk + (bid >> 3); step = per; end = min(T, (xcd + 1) * chunk);
  } else { start = bid; step = G; end = T; }
  const int lrow = lane >> 3;
  const int lsrc0 = ((lane & 7) ^ ((lane >> 4) & 7)) * 8;
  const int lsrc1 = ((lane & 7) ^ ((4 + (lane >> 4)) & 7)) * 8;
  const int fsw = (lane >> 1) & 7;
  const int ncols = min(256, d.N);
  const bool active = wc * 64 < ncols;
  for (int t = start; t < end; t += step) {
    const int n = t % nN; const int r = t / nN; const int m = r % nM; const int b = r / nM;
    const u16* Ab = d.A + (long)b * d.a_bs + (long)(m * 256) * d.lda;
    const u16* A2b = d.A2 ? d.A2 + (long)b * d.a2_bs + (long)(m * 256) * d.lda2 : nullptr;
    const u16* Bb = d.Bt + (long)b * d.b_bs + (long)(n * 256) * d.ldb;
    f32x4 acc[8][4];
#pragma unroll
    for (int i = 0; i < 8; ++i)
#pragma unroll
      for (int j = 0; j < 4; ++j) acc[i][j] = (f32x4){0.f, 0.f, 0.f, 0.f};
#define STAGE(kt_, s_) do { \
      const int k0_ = (kt_) * 64; \
      const u16* ap_; long ld_; \
      if (k0_ < d.ksplit) { ap_ = Ab + k0_; ld_ = d.lda; } else { ap_ = A2b + (k0_ - d.ksplit); ld_ = d.lda2; } \
      char* sa_ = smem + (s_) * 65536; \
      _Pragma("unroll") for (int j = 0; j < 4; ++j) { \
        const int g_ = wid * 4 + j;     \
        const int ls_ = (j & 1) ? lsrc1 : lsrc0; \
        __builtin_amdgcn_global_load_lds((const unsigned*)(ap_ + (long)(g_ * 8 + lrow) * ld_ + ls_), \
                                         (unsigned*)(sa_ + g_ * 1024 + lane * 16), 16, 0, 0); \
        const int br_ = (g_ * 8 + lrow) & (ncols - 1);     \
        __builtin_amdgcn_global_load_lds((const unsigned*)(Bb + (long)br_ * d.ldb + k0_ + ls_), \
                                         (unsigned*)(sa_ + 32768 + g_ * 1024 + lane * 16), 16, 0, 0); \
      } \
    } while (0)
    __syncthreads();
    STAGE(0, 0);
    asm volatile("s_waitcnt vmcnt(0)" ::: "memory");
    __builtin_amdgcn_s_barrier();
    const int arow = (wr * 128 + (lane & 15)) * 128, brow = 32768 + (wc * 64 + (lane & 15)) * 128;
    for (int kt = 0; kt < nk; ++kt) {
      const int s = kt & 1;
      if (kt + 1 < nk) STAGE(kt + 1, s ^ 1);
      if (active) {
        const char* sb = smem + s * 65536;
#pragma unroll 1
        for (int kh = 0; kh < 2; ++kh) {
          bf16x8 fa[8], fb[4];
          const int co = (((4 * kh + (lane >> 4)) ^ fsw) * 16);
#pragma unroll
          for (int nt = 0; nt < 4; ++nt) fb[nt] = *(const bf16x8*)(sb + brow + nt * 16 * 128 + co);
          fa[0] = *(const bf16x8*)(sb + arow + co);
          fa[1] = *(const bf16x8*)(sb + arow + 16 * 128 + co);
          __builtin_amdgcn_sched_barrier(0);
          acc[0][0] = __builtin_amdgcn_mfma_f32_16x16x32_bf16(fb[0], fa[0], acc[0][0], 0, 0, 0);
          __builtin_amdgcn_sched_barrier(0);
#pragma unroll
          for (int mt = 2; mt < 8; ++mt) fa[mt] = *(const bf16x8*)(sb + arow + mt * 16 * 128 + co);
          __builtin_amdgcn_sched_barrier(0);
#pragma unroll
          for (int nt = 1; nt < 4; ++nt)
            acc[0][nt] = __builtin_amdgcn_mfma_f32_16x16x32_bf16(fb[nt], fa[0], acc[0][nt], 0, 0, 0);
#pragma unroll
          for (int nt = 0; nt < 4; ++nt)
            acc[1][nt] = __builtin_amdgcn_mfma_f32_16x16x32_bf16(fb[nt], fa[1], acc[1][nt], 0, 0, 0);
          __builtin_amdgcn_sched_barrier(0);
#pragma unroll
          for (int mt = 2; mt < 8; ++mt)
#pragma unroll
            for (int nt = 0; nt < 4; ++nt)
              acc[mt][nt] = __builtin_amdgcn_mfma_f32_16x16x32_bf16(fb[nt], fa[mt], acc[mt][nt], 0, 0, 0);
          __builtin_amdgcn_sched_barrier(0);
        }
      }
      asm volatile("s_waitcnt vmcnt(0)" ::: "memory");
      __builtin_amdgcn_s_barrier();
    }
    float* sC = (float*)smem;
#pragma unroll
    for (int q = 0; q < 2; ++q) {
      if (q) __syncthreads();
      if (active) {
#pragma unroll
        for (int mt2 = 0; mt2 < 4; ++mt2)
#pragma unroll
          for (int nt = 0; nt < 4; ++nt)
            *(f32x4*)(sC + (wr * 64 + mt2 * 16 + (lane & 15)) * CLD + wc * 64 + nt * 16 + 4 * (lane >> 4)) = acc[4 * q + mt2][nt];
      }
      __syncthreads();
      run_epilogue(p, l, epi, b, m * 256 + q * 64, n * 256, tid, sC, ncols);
    }
  }
}

__device__ __forceinline__ uint2 pack4(float4 v) {
  uint2 pk;
  pk.x = pack2(v.x, v.y);
  pk.y = pack2(v.z, v.w);
  return pk;
}
__device__ __forceinline__ float4 unpack4(uint2 u) {
  float4 v;
  v.x = __uint_as_float(u.x << 16); v.y = __uint_as_float(u.x & 0xffff0000u);
  v.z = __uint_as_float(u.y << 16); v.w = __uint_as_float(u.y & 0xffff0000u);
  return v;
}
template <class F>
__device__ __forceinline__ void epi_each(int row0, int col0, int tid, const float* sC, int ncols, const F& f) {
#pragma unroll 2
  for (int j = 0; j < 16; ++j) {
    const int e = tid + NTHR * j;
    const int r = e >> 6, c = (e & 63) * 4;
    if (c < ncols) {
      const float4 v = *(const float4*)(sC + r * CLD + c);
      f(row0 + r + (r & 64), col0 + c, v);
    }
  }
}

struct EpiInProj {
  u16 *qb, *qi, *ki, *sga, *sgs, *ugm, *cn; float *wi; const float* kvg;
  __device__ __forceinline__ void run(int b, int row0, int col0, int tid, const float* sC, int ncols) const {
    const EpiInProj& s = *this;
    if (col0 == 512) {
      const int lane = tid & 63;
      const float4 gv = *(const float4*)(s.kvg + (lane & 31) * 4);
#pragma unroll 2
      for (int j = 0; j < 16; ++j) {
        const int e = tid + NTHR * j;
        const int r = e >> 6, c = (e & 63) * 4;
        const float4 v = *(const float4*)(sC + r * CLD + c);
        const long row = row0 + r + (r & 64);
        float ss = v.x * v.x + v.y * v.y + v.z * v.z + v.w * v.w;
        ss += __shfl_xor(ss, 16); ss += __shfl_xor(ss, 8); ss += __shfl_xor(ss, 4); ss += __shfl_xor(ss, 2); ss += __shfl_xor(ss, 1);
        if (c < 128) {
          const float rs = rsqrtf(ss * (1.f / 128.f) + 1e-6f);
          float4 w; w.x = v.x * rs * gv.x; w.y = v.y * rs * gv.y; w.z = v.z * rs * gv.z; w.w = v.w * rs * gv.w;
          *(uint2*)(s.cn + row * 128 + c) = pack4(w);
        } else {
          *(uint2*)(s.qi + row * 256 + (c - 128)) = pack4(v);
        }
      }
      return;
    }
    epi_each(row0, col0, tid, sC, ncols, [&](int row, int col, float4 v) {
      if (col < 512) *(uint2*)(s.qb + (long)row * 512 + col) = pack4(v);
      else if (col < 896) *(uint2*)(s.qi + (long)row * 256 + (col - 640)) = pack4(v);
      else if (col < 928) *(uint2*)(s.ki + (long)row * 32 + (col - 896)) = pack4(v);
      else if (col < 936) { float4 w = v; w.x *= 0.0625f; w.y *= 0.0625f; w.z *= 0.0625f; w.w *= 0.0625f; *(float4*)(s.wi + (long)row * 8 + (col - 928)) = w; }
      else if (col < 1024) {}
      else if (col < 1536) { float4 w; w.x = silu_f(v.x); w.y = silu_f(v.y); w.z = silu_f(v.z); w.w = silu_f(v.w); *(uint2*)(s.sga + (long)row * 512 + (col - 1024)) = pack4(w); }
      else if (col < 2048) { int cc = col - 1536; *(uint2*)(s.ugm + ((long)(cc >> 4) * NTOK + row) * 16 + (cc & 15)) = pack4(v); }
      else { float4 w; w.x = silu_f(v.x); w.y = silu_f(v.y); w.z = silu_f(v.z); w.w = silu_f(v.w); *(uint2*)(s.sgs + (long)row * 512 + (col - 2048)) = pack4(w); }
    });
  }
};
struct EpiQlat {
  u16* ql;
  __device__ __forceinline__ void run(int b, int row0, int col0, int tid, const float* sC, int ncols) const {
    u16* o = ql;
    epi_each(row0, col0, tid, sC, ncols, [&](int row, int col, float4 v) { *(uint2*)(o + (long)row * 1024 + b * 128 + col) = pack4(v); });
  }
};
struct EpiS {
  float* S;
  __device__ __forceinline__ void run(int b, int row0, int col0, int tid, const float* sC, int ncols) const {
    float* o = S;
    epi_each(row0, col0, tid, sC, ncols, [&](int row, int col, float4 v) { *(float4*)(o + ((long)b * NCHUNK + row) * 128 + col) = v; });
  }
};
struct EpiUv {
  const u16* sga; u16* mixed;
  __device__ __forceinline__ void run(int b, int row0, int col0, int tid, const float* sC, int ncols) const {
    const u16* g = sga; u16* o = mixed;
    epi_each(row0, col0, tid, sC, ncols, [&](int row, int col, float4 v) {
      int c2 = b * 128 + col;
      float4 gv = unpack4(*(const uint2*)(g + (long)row * 512 + c2));
      float4 w; w.x = v.x * gv.x; w.y = v.y * gv.y; w.z = v.z * gv.z; w.w = v.w * gv.w;
      *(uint2*)(o + (long)row * 1024 + c2) = pack4(w);
    });
  }
};
struct EpiY {
  const u16* ugm; const float* dsk; u16* yact;
  __device__ __forceinline__ void run(int b, int row0, int col0, int tid, const float* sC, int ncols) const {
    const u16* u = ugm; const float* dd = dsk; u16* o = yact;
    epi_each(row0, col0, tid, sC, ncols, [&](int row, int col, float4 v) {
      int t = col >> 4, c = col & 15;
      long token = (long)row * TCH + t;
      float4 uv = unpack4(*(const uint2*)(u + ((long)b * NTOK + token) * 16 + c));
      float4 dv = *(const float4*)(dd + b * 16 + c);
      float4 w;
      w.x = gelu_tanh(v.x + dv.x * uv.x); w.y = gelu_tanh(v.y + dv.y * uv.y);
      w.z = gelu_tanh(v.z + dv.z * uv.z); w.w = gelu_tanh(v.w + dv.w * uv.w);
      *(uint2*)(o + token * 512 + b * 16 + c) = pack4(w);
    });
  }
};
struct EpiGlu {
  const u16* sgs; const float* bglu; u16* mixed;
  __device__ __forceinline__ void run(int b, int row0, int col0, int tid, const float* sC, int ncols) const {
#pragma unroll 2
    for (int jj = 0; jj < 8; ++jj) {
      const int e = tid + NTHR * jj;
      const int r = e >> 5, q = e & 31, gi = q >> 3, qq = q & 7;
      const float4 va = *(const float4*)(sC + r * CLD + gi * 64 + qq * 4);
      const float4 ga = *(const float4*)(sC + r * CLD + gi * 64 + 32 + qq * 4);
      const int j = (col0 >> 1) + gi * 32 + qq * 4;
      const long row = row0 + r + (r & 64);
      const float4 bv = *(const float4*)(bglu + j), bg = *(const float4*)(bglu + 512 + j);
      const float4 sg = unpack4(*(const uint2*)(sgs + row * 512 + j));
      float4 w;
      w.x = (va.x + bv.x) * sigmoid_fast(ga.x + bg.x) * sg.x;
      w.y = (va.y + bv.y) * sigmoid_fast(ga.y + bg.y) * sg.y;
      w.z = (va.z + bv.z) * sigmoid_fast(ga.z + bg.z) * sg.z;
      w.w = (va.w + bv.w) * sigmoid_fast(ga.w + bg.w) * sg.w;
      *(uint2*)(mixed + row * 1024 + 512 + j) = pack4(w);
    }
  }
};
struct EpiOut {
  const float* xin; float* z; const float* stats; const float* g; const float* bb; int first;
  __device__ __forceinline__ void run(int b, int row0, int col0, int tid, const float* sC, int ncols) const {
    const EpiOut& s = *this;
    epi_each(row0, col0, tid, sC, ncols, [&](int row, int col, float4 v) {
      long idx = (long)row * 1024 + col;
      float4 xp;
      if (s.first) xp = *(const float4*)(s.xin + idx);
      else {
        float mu = s.stats[2 * row], rs = s.stats[2 * row + 1];
        float4 zo = *(const float4*)(s.z + idx), gv = *(const float4*)(s.g + col), bv = *(const float4*)(s.bb + col);
        xp.x = (zo.x - mu) * rs * gv.x + bv.x; xp.y = (zo.y - mu) * rs * gv.y + bv.y;
        xp.z = (zo.z - mu) * rs * gv.z + bv.z; xp.w = (zo.w - mu) * rs * gv.w + bv.w;
      }
      float4 o; o.x = ALPHA * xp.x + v.x; o.y = ALPHA * xp.y + v.y; o.z = ALPHA * xp.z + v.z; o.w = ALPHA * xp.w + v.w;
      *(float4*)(s.z + idx) = o;
    });
  }
};

template <class CM>
__device__ __forceinline__ void transpose_tile(const Ctx& cx, const float* src, int sld, u16* dst, int dld, int k0, int n0, const CM& colmap, char* smem) {
  float* tile = (float*)smem;
  const int tid = cx.tid;
  __syncthreads();
  for (int e = tid; e < 4096; e += NTHR) {
    int kk = e >> 6, nn = e & 63;
    int sc = colmap(n0 + nn);
    tile[kk * 65 + nn] = sc >= 0 ? src[(long)(k0 + kk) * sld + sc] : 0.f;
  }
  __syncthreads();
  for (int e = tid; e < 4096; e += NTHR) {
    int nn = e >> 6, kk = e & 63;
    dst[(long)(n0 + nn) * dld + k0 + kk] = f2bf(tile[kk * 65 + nn]);
  }
}

__device__ __forceinline__ void ssm_ops(const Ctx& cx, const Params& p, int l, int g, char* smem) {
  float* ap = (float*)smem;
  float* bbm = ap + 17 * 64 * 2;
  float* ccm = bbm + 64 * 16 * 2;
  float* kj = ccm + 16 * 64 * 2;
  const int tid = cx.tid;
  const int lg = l * NGRP + g;
  __syncthreads();
  if (tid < 64) {
    const int pp = tid;
    float dt = expf(p.log_dt[lg]);
    float lr = p.a_re[lg * 64 + pp], li = p.a_im[lg * 64 + pp];
    for (int j = 0; j <= 16; ++j) {
      float mag = expf(lr * dt * (float)j);
      float sn, cs; sincosf(li * dt * (float)j, &sn, &cs);
      ap[(j * 64 + pp) * 2] = mag * cs; ap[(j * 64 + pp) * 2 + 1] = mag * sn;
    }
    float ar = ap[(1 * 64 + pp) * 2], ai = ap[(1 * 64 + pp) * 2 + 1];
    float den = lr * lr + li * li;
    float cr = ((ar - 1.f) * lr + ai * li) / den;
    float ci = (ai * lr - (ar - 1.f) * li) / den;
    for (int c = 0; c < 16; ++c) {
      float br = p.b_re[((long)lg * 64 + pp) * 16 + c], bi = p.b_im[((long)lg * 64 + pp) * 16 + c];
      bbm[(pp * 16 + c) * 2] = cr * br - ci * bi;
      bbm[(pp * 16 + c) * 2 + 1] = cr * bi + ci * br;
    }
    float* at = (float*)(p.ws + OFF_AT) + ((long)lg * 64 + pp) * 2;
    at[0] = ap[(16 * 64 + pp) * 2]; at[1] = ap[(16 * 64 + pp) * 2 + 1];
  }
  for (int e = tid; e < 1024; e += NTHR) {
    ccm[e * 2] = p.c_re[(long)lg * 1024 + e];
    ccm[e * 2 + 1] = p.c_im[(long)lg * 1024 + e];
  }
  __syncthreads();
  for (int e = tid; e < 4096; e += NTHR) {
    int j = e >> 8, cp = (e >> 4) & 15, c = e & 15;
    float s = 0.f;
    for (int pp = 0; pp < 64; ++pp) {
      float c_r = ccm[(cp * 64 + pp) * 2], c_i = ccm[(cp * 64 + pp) * 2 + 1];
      float a_r = ap[(j * 64 + pp) * 2], a_i = ap[(j * 64 + pp) * 2 + 1];
      float er = c_r * a_r - c_i * a_i, ei = c_r * a_i + c_i * a_r;
      s += er * bbm[(pp * 16 + c) * 2] - ei * bbm[(pp * 16 + c) * 2 + 1];
    }
    kj[e] = s;
  }
  __syncthreads();
  u16* op2 = (u16*)(p.ws + OFF_OP2) + (long)lg * 256 * 384;
  for (int e = tid; e < 256 * 384; e += NTHR) {
    int n = e / 384, k = e - n * 384;
    int t = n >> 4, cp = n & 15;
    float v;
    if (k < 256) {
      int s = k >> 4, c = k & 15;
      v = (s <= t) ? kj[((t - s) * 16 + cp) * 16 + c] : 0.f;
    } else {
      int j = k - 256, pp = j & 63;
      float c_r = ccm[(cp * 64 + pp) * 2], c_i = ccm[(cp * 64 + pp) * 2 + 1];
      float a_r = ap[((t + 1) * 64 + pp) * 2], a_i = ap[((t + 1) * 64 + pp) * 2 + 1];
      v = (j < 64) ? (c_r * a_r - c_i * a_i) : -(c_r * a_i + c_i * a_r);
    }
    op2[e] = f2bf(v);
  }
  u16* op1 = (u16*)(p.ws + OFF_OP1) + (long)lg * 128 * 256;
  for (int e = tid; e < 128 * 256; e += NTHR) {
    int j = e >> 8, k = e & 255;
    int pp = j & 63, s = k >> 4, c = k & 15;
    float a_r = ap[((15 - s) * 64 + pp) * 2], a_i = ap[((15 - s) * 64 + pp) * 2 + 1];
    float b_r = bbm[(pp * 16 + c) * 2], b_i = bbm[(pp * 16 + c) * 2 + 1];
    float v = (j < 64) ? (a_r * b_r - a_i * b_i) : (a_r * b_i + a_i * b_r);
    op1[e] = f2bf(v);
  }
}

__device__ __forceinline__ void prologue_phase(const Ctx& cx, const Params& p, char* smem) {
  const int G = cx.G, bid = cx.bid, tid = cx.tid;
  for (int it = bid; it < DEPTH * NGRP; it += G) ssm_ops(cx, p, it / NGRP, it % NGRP, smem);
  for (int it = bid; it < DEPTH * 16 * 40; it += G) {
    int l = it / 640, r = it % 640, kt = r / 40, ntile = r % 40;
    transpose_tile(cx, p.w_in + (long)l * DM * DIN, DIN, (u16*)(p.ws + OFF_WINT) + (long)l * NPAD * DM, DM, kt * 64, ntile * 64,
                   [](int n) { return n < 936 ? n : (n < 1024 ? -1 : n - 88); }, smem);
  }
  for (int it = bid; it < DEPTH * 256; it += G) {
    int l = it >> 8, r = it & 255, kt = r >> 4, ntile = r & 15;
    transpose_tile(cx, p.w_out + (long)l * DM * DM, DM, (u16*)(p.ws + OFF_WOUTT) + (long)l * DM * DM, DM, kt * 64, ntile * 64,
                   [](int n) { return n; }, smem);
  }
  for (int it = bid; it < DEPTH * 128; it += G) {
    int l = it >> 7, r = it & 127, kt = r >> 4, ntile = r & 15;
    transpose_tile(cx, p.w_glu + (long)l * 512 * 1024, 1024, (u16*)(p.ws + OFF_WGLUT) + (long)l * 1024 * 512, 512, kt * 64, ntile * 64,
                   [](int n) { return ((n >> 5) & 1) * 512 + (n >> 6) * 32 + (n & 31); }, smem);
  }
  const long gtid = (long)bid * NTHR + tid, gsz = (long)G * NTHR;
  {
    u16* o = (u16*)(p.ws + OFF_WUK);
    for (long e = gtid; e < (long)DEPTH * 8 * 128 * 64; e += gsz) o[e] = f2bf(0.125f * 1.4426950408889634f * p.w_uk[e]);
  }
  {
    u16* o = (u16*)(p.ws + OFF_WUVP);
    for (long e = gtid; e < (long)DEPTH * 4 * 128 * 256; e += gsz) {
      int k = e & 255, n = (e >> 8) & 127, j = (e >> 15) & 3, l = (int)(e >> 17);
      int hh = n >> 6, dd = n & 63, hh2 = k >> 7, c = k & 127;
      float v = (hh == hh2) ? p.w_uv[(((long)l * 8 + 2 * j + hh) * 128 + c) * 64 + dd] : 0.f;
      o[e] = f2bf(v);
    }
  }
  {
    u16* o = (u16*)(p.ws + OFF_XB);
    const float4* xi = (const float4*)p.x;
    for (long e = gtid; e < (long)NTOK * DM / 4; e += gsz) {
      float4 v = xi[e];
      uint2 pk;
      pk.x = pack2(v.x, v.y);
      pk.y = pack2(v.z, v.w);
      *(uint2*)(o + e * 4) = pk;
    }
  }
}

__device__ __forceinline__ void rmsnorm_pass(const Ctx& cx, const Params& p, int l) {
  const float* ckv = (const float*)(p.ws + OFF_CKV);
  u16* cn = (u16*)(p.ws + OFF_CN);
  const float* g = p.kvg + l * 128;
  const int lane = cx.tid & 63, half = lane >> 5, l32 = lane & 31;
  const long gw = (long)cx.bid * NWV + (cx.tid >> 6), nw = (long)cx.G * NWV;
  const float4 gv = *(const float4*)(g + l32 * 4);
  for (long it = gw; it < NTOK / 2; it += nw) {
    long tok = it * 2 + half;
    float4 v = *(const float4*)(ckv + tok * 128 + l32 * 4);
    float ss = v.x * v.x + v.y * v.y + v.z * v.z + v.w * v.w;
    ss += __shfl_xor(ss, 16); ss += __shfl_xor(ss, 8); ss += __shfl_xor(ss, 4); ss += __shfl_xor(ss, 2); ss += __shfl_xor(ss, 1);
    float rs = rsqrtf(ss * (1.f / 128.f) + 1e-6f);
    uint2 pk;
    pk.x = pack2(v.x * rs * gv.x, v.y * rs * gv.y);
    pk.y = pack2(v.z * rs * gv.z, v.w * rs * gv.w);
    *(uint2*)(cn + tok * 128 + l32 * 4) = pk;
  }
}

__device__ __forceinline__ void layernorm_pass(const Ctx& cx, const Params& p, int l) {
  float* z = p.out;
  float* stats = (float*)(p.ws + OFF_STATS);
  u16* xb = (u16*)(p.ws + OFF_XB);
  const float* g = p.ln_g + l * DM; const float* bb = p.ln_b + l * DM;
  const int lane = cx.tid & 63;
  const long gw = (long)cx.bid * NWV + (cx.tid >> 6), nw = (long)cx.G * NWV;
  float4 gv[4], bv[4];
#pragma unroll
  for (int j = 0; j < 4; ++j) { gv[j] = *(const float4*)(g + j * 256 + lane * 4); bv[j] = *(const float4*)(bb + j * 256 + lane * 4); }
  for (long row = gw; row < NTOK; row += nw) {
    float4 v[4];
    float s = 0.f;
#pragma unroll
    for (int j = 0; j < 4; ++j) { v[j] = *(const float4*)(z + row * DM + j * 256 + lane * 4); s += v[j].x + v[j].y + v[j].z + v[j].w; }
#pragma unroll
    for (int o = 32; o >= 1; o >>= 1) s += __shfl_xor(s, o);
    float mu = s * (1.f / 1024.f);
    float q = 0.f;
#pragma unroll
    for (int j = 0; j < 4; ++j) {
      float a = v[j].x - mu, b = v[j].y - mu, c = v[j].z - mu, d = v[j].w - mu;
      q += a * a + b * b + c * c + d * d;
    }
#pragma unroll
    for (int o = 32; o >= 1; o >>= 1) q += __shfl_xor(q, o);
    float rs = rsqrtf(q * (1.f / 1024.f) + 1e-5f);
    if (l == DEPTH - 1) {
#pragma unroll
      for (int j = 0; j < 4; ++j) {
        float4 o;
        o.x = (v[j].x - mu) * rs * gv[j].x + bv[j].x; o.y = (v[j].y - mu) * rs * gv[j].y + bv[j].y;
        o.z = (v[j].z - mu) * rs * gv[j].z + bv[j].z; o.w = (v[j].w - mu) * rs * gv[j].w + bv[j].w;
        *(float4*)(z + row * DM + j * 256 + lane * 4) = o;
      }
    } else {
      if (lane == 0) { stats[2 * row] = mu; stats[2 * row + 1] = rs; }
#pragma unroll
      for (int j = 0; j < 4; ++j) {
        float a = (v[j].x - mu) * rs * gv[j].x + bv[j].x, b = (v[j].y - mu) * rs * gv[j].y + bv[j].y;
        float c = (v[j].z - mu) * rs * gv[j].z + bv[j].z, d = (v[j].w - mu) * rs * gv[j].w + bv[j].w;
        uint2 pk;
        pk.x = pack2(a, b);
        pk.y = pack2(c, d);
        *(uint2*)(xb + row * DM + j * 256 + lane * 4) = pk;
      }
    }
  }
}

__device__ __forceinline__ void scan_pass(const Ctx& cx, const Params& p, int l) {
  const float* S = (const float*)(p.ws + OFF_S);
  u16* Xin = (u16*)(p.ws + OFF_CKV);
  const int lane = cx.tid & 63;
  const int gw = cx.bid * NWV + (cx.tid >> 6), nw = cx.G * NWV;
  for (int it = gw; it < NBATCH * NGRP; it += nw) {
    int b = it >> 5, g = it & 31;
    const float* at = (const float*)(p.ws + OFF_AT) + ((long)(l * NGRP + g) * 64 + lane) * 2;
    const float ar = at[0], ai = at[1];
    float xr = 0.f, xi = 0.f;
    long row0 = (long)g * NCHUNK + b * 256;
    for (int k0 = 0; k0 < 256; k0 += 32) {
      float sr[32], si[32];
#pragma unroll
      for (int j = 0; j < 32; ++j) { sr[j] = S[(row0 + k0 + j) * 128 + lane]; si[j] = S[(row0 + k0 + j) * 128 + 64 + lane]; }
#pragma unroll
      for (int j = 0; j < 32; ++j) {
        Xin[(row0 + k0 + j) * 128 + lane] = f2bf(xr);
        Xin[(row0 + k0 + j) * 128 + 64 + lane] = f2bf(xi);
        float nr = ar * xr - ai * xi + sr[j];
        float ni = ar * xi + ai * xr + si[j];
        xr = nr; xi = ni;
      }
    }
  }
}

__device__ __forceinline__ unsigned sortable(float f) {
  unsigned u = __float_as_uint(f);
  return u ^ ((unsigned)((int)u >> 31) | 0x80000000u);
}
__device__ __forceinline__ int mbcnt64(u64 m) {
  return __builtin_amdgcn_mbcnt_hi((unsigned)(m >> 32), __builtin_amdgcn_mbcnt_lo((unsigned)m, 0));
}

__device__ __forceinline__ void attn_phase(const Ctx& cx, const Params& p, char* smem) {
  const u16* qi = (const u16*)(p.ws + OFF_QI);
  const u16* ki = (const u16*)(p.ws + OFF_KI);
  const float* wi = (const float*)(p.ws + OFF_WI);
  const u16* cn = (const u16*)(p.ws + OFF_CN);
  u16* ql = (u16*)(p.ws + OFF_QL);
  const int tid = cx.tid, lane = tid & 63, wid = __builtin_amdgcn_readfirstlane(tid >> 6);
  const int hh = lane >> 5;
  const int G = cx.G;
  for (int item = cx.bid; item < (SEQL / 8) * NBATCH; item += G) {
    const int tq = (SEQL / 8 - 1) - (item >> 4), b = item & 15;
    const int t0 = tq * 8;
    const long tokbase = (long)b * SEQL;
    {
      const int r = lane & 31;
      const int qq = 2 * ((r >> 2) & 1) + (r >> 4), head = (r & 3) + 4 * ((r >> 3) & 1);
      const u16* qip = qi + (tokbase + t0 + qq) * 256 + head * 32 + 8 * hh;
      const bf16x8 qa0 = *(const bf16x8*)qip, qa1 = *(const bf16x8*)(qip + 16);
      const bf16x8 qb0 = *(const bf16x8*)(qip + 4 * 256), qb1 = *(const bf16x8*)(qip + 4 * 256 + 16);
      float w0[8], w1[8], w2[8], w3[8];
      {
        const float4* wp = (const float4*)(wi + (tokbase + t0 + 2 * hh) * 8);
        float4 a = wp[0], bq = wp[1], c = wp[2], d = wp[3];
        w0[0] = a.x; w0[1] = a.y; w0[2] = a.z; w0[3] = a.w; w0[4] = bq.x; w0[5] = bq.y; w0[6] = bq.z; w0[7] = bq.w;
        w1[0] = c.x; w1[1] = c.y; w1[2] = c.z; w1[3] = c.w; w1[4] = d.x; w1[5] = d.y; w1[6] = d.z; w1[7] = d.w;
        const float4* wq = (const float4*)(wi + (tokbase + t0 + 4 + 2 * hh) * 8);
        a = wq[0]; bq = wq[1]; c = wq[2]; d = wq[3];
        w2[0] = a.x; w2[1] = a.y; w2[2] = a.z; w2[3] = a.w; w2[4] = bq.x; w2[5] = bq.y; w2[6] = bq.z; w2[7] = bq.w;
        w3[0] = c.x; w3[1] = c.y; w3[2] = c.z; w3[3] = c.w; w3[4] = d.x; w3[5] = d.y; w3[6] = d.z; w3[7] = d.w;
      }
      const int ntiles = ((t0 + 7) >> 5) + 1;
      const int q0 = t0 + 2 * hh;
      unsigned* sc0 = (unsigned*)(smem + (2 * hh) * REG_STRIDE);
      unsigned* sc1 = (unsigned*)(smem + (2 * hh + 1) * REG_STRIDE);
      unsigned* sc2 = (unsigned*)(smem + (4 + 2 * hh) * REG_STRIDE);
      unsigned* sc3 = (unsigned*)(smem + (4 + 2 * hh + 1) * REG_STRIDE);
      __syncthreads();
      bf16x8 nk0, nk1;
      {
        const u16* kp = ki + (tokbase + min(wid, ntiles - 1) * 32 + r) * 32 + 8 * hh;
        nk0 = *(const bf16x8*)kp; nk1 = *(const bf16x8*)(kp + 16);
      }
      for (int tile = wid; tile < ntiles; tile += NWV) {
        const int key = tile * 32 + r;
        const bf16x8 kb0 = nk0, kb1 = nk1;
        {
          const u16* kp = ki + (tokbase + min(tile + NWV, ntiles - 1) * 32 + r) * 32 + 8 * hh;
          nk0 = *(const bf16x8*)kp; nk1 = *(const bf16x8*)(kp + 16);
        }
        f32x16 acc, acd;
#pragma unroll
        for (int e = 0; e < 16; ++e) { acc[e] = 0.f; acd[e] = 0.f; }
        acc = __builtin_amdgcn_mfma_f32_32x32x16_bf16(qa0, kb0, acc, 0, 0, 0);
        acd = __builtin_amdgcn_mfma_f32_32x32x16_bf16(qb0, kb0, acd, 0, 0, 0);
        acc = __builtin_amdgcn_mfma_f32_32x32x16_bf16(qa1, kb1, acc, 0, 0, 0);
        acd = __builtin_amdgcn_mfma_f32_32x32x16_bf16(qb1, kb1, acd, 0, 0, 0);
        float s0 = 0.f, s1 = 0.f, s2 = 0.f, s3 = 0.f;
#pragma unroll
        for (int e = 0; e < 8; ++e) {
          s0 += w0[e] * fmaxf(acc[e], 0.f); s1 += w1[e] * fmaxf(acc[8 + e], 0.f);
          s2 += w2[e] * fmaxf(acd[e], 0.f); s3 += w3[e] * fmaxf(acd[8 + e], 0.f);
        }
        sc0[key] = (key <= q0) ? sortable(s0) : 0u;
        sc1[key] = (key <= q0 + 1) ? sortable(s1) : 0u;
        sc2[key] = (key <= q0 + 4) ? sortable(s2) : 0u;
        sc3[key] = (key <= q0 + 5) ? sortable(s3) : 0u;
      }
      __syncthreads();
    }
    const int t = t0 + wid;
    char* reg = smem + wid * REG_STRIDE;
    const unsigned* sc = (const unsigned*)reg;
    u16* sel = (u16*)(reg + 18432);
    const int nvalid = t + 1;
    int count;
    if (nvalid <= 256) {
      count = nvalid;
      for (int i = lane; i < 256; i += 64) sel[i] = (u16)(i < nvalid ? i : 0);
    } else {
      count = 256;
      unsigned v[64];
#pragma unroll
      for (int i = 0; i < 64; ++i) { int key = i * 64 + lane; v[i] = (key < nvalid) ? sc[key] : 0u; }
      const int ni = (nvalid + 63) >> 6;
#define CNT_GE(THR, CNT) do { \
        int c_ = 0; \
        _Pragma("unroll") for (int gq = 0; gq < 4; ++gq) { \
          if (gq * 16 < ni) { \
            _Pragma("unroll") for (int j = 0; j < 16; ++j) c_ += __builtin_popcountll(__ballot(v[gq * 16 + j] >= (THR))); \
          } \
        } \
        CNT = c_; } while (0)
      unsigned vmax = 0u;
#pragma unroll
      for (int i = 0; i < 64; ++i) vmax = max(vmax, v[i]);
#pragma unroll
      for (int o = 32; o >= 1; o >>= 1) vmax = max(vmax, (unsigned)__shfl_xor((int)vmax, o));
      vmax = (unsigned)__builtin_amdgcn_readfirstlane((int)vmax);
      unsigned lo = 0u, hi = vmax + 1u;
      int clo = 4096, chi = 0;
      bool positive = false;
      {
        int c0; CNT_GE(0x80000000u, c0);
        if (c0 >= 256) { lo = 0x80000000u; clo = c0; positive = true; }
        else { hi = 0x80000000u; chi = c0; }
      }
      while (clo != 256 && clo - chi > 128 && hi - lo > 1u) {
        unsigned mid = lo + ((hi - lo) >> 1);
        if (positive) {
          const float fm = 0.5f * (__uint_as_float(lo & 0x7fffffffu) + __uint_as_float(hi & 0x7fffffffu));
          const unsigned m2 = __float_as_uint(fm) | 0x80000000u;
          if (m2 > lo && m2 < hi) mid = m2;
        }
        int cnt; CNT_GE(mid, cnt);
        if (cnt >= 256) { lo = mid; clo = cnt; } else { hi = mid; chi = cnt; }
      }
      if (clo <= 384) {
        unsigned* dval = (unsigned*)(reg + 8192);
        u16* dkey = (u16*)(reg + 8192 + 1536);
        {
          int base = 0;
#pragma unroll
          for (int gq = 0; gq < 4; ++gq) {
            if (gq * 16 < ni) {
#pragma unroll
              for (int j = 0; j < 16; ++j) {
                const int i = gq * 16 + j;
                const bool in = v[i] >= lo;
                const u64 m = __ballot(in);
                if (in) { const int pos = base + mbcnt64(m); dval[pos] = v[i]; dkey[pos] = (u16)(i * 64 + lane); }
                base += __builtin_popcountll(m);
              }
            }
          }
        }
        unsigned dv[6]; int dk[6];
#pragma unroll
        for (int j = 0; j < 6; ++j) {
          const int idx = j * 64 + lane;
          dv[j] = (idx < clo) ? dval[idx] : 0u;
          dk[j] = (idx < clo) ? (int)dkey[idx] : 0;
        }
        while (clo != 256 && hi - lo > 1u) {
          const unsigned mid = lo + ((hi - lo) >> 1);
          int cnt = 0;
#pragma unroll
          for (int j = 0; j < 6; ++j) cnt += __builtin_popcountll(__ballot(dv[j] >= mid));
          if (cnt >= 256) { lo = mid; clo = cnt; } else { hi = mid; chi = cnt; }
        }
        int base = 0, eqleft = (clo == 256) ? 512 : 256 - chi;
#pragma unroll
        for (int j = 0; j < 6; ++j) {
          const bool gt = dv[j] > lo, eq = dv[j] == lo;
          const u64 meq = __ballot(eq);
          const bool take = gt || (eq && mbcnt64(meq) < eqleft);
          const u64 mt = __ballot(take);
          if (take) sel[base + mbcnt64(mt)] = (u16)dk[j];
          base += __builtin_popcountll(mt);
          eqleft -= min((int)__builtin_popcountll(meq), eqleft);
        }
      } else {
        int base = 0, eqleft = 256 - chi;
#pragma unroll
        for (int gq = 0; gq < 4; ++gq) {
          if (gq * 16 < ni) {
#pragma unroll
            for (int j = 0; j < 16; ++j) {
              const int i = gq * 16 + j;
              const bool gt = v[i] > lo, eq = v[i] == lo;
              const u64 meq = __ballot(eq);
              const bool take = gt || (eq && mbcnt64(meq) < eqleft);
              const u64 mt = __ballot(take);
              if (take) sel[base + mbcnt64(mt)] = (u16)(i * 64 + lane);
              base += __builtin_popcountll(mt);
              eqleft -= min((int)__builtin_popcountll(meq), eqleft);
              if ((j & 3) == 3) __builtin_amdgcn_sched_barrier(0);
            }
          }
        }
      }
    }
    {
      const long token = tokbase + t;
      const int hd = lane & 15, g4 = lane >> 4;
      bf16x8 qf[4];
#pragma unroll
      for (int ks = 0; ks < 4; ++ks) {
        if (hd < 8) qf[ks] = *(const bf16x8*)(ql + token * 1024 + hd * 128 + 32 * ks + 8 * g4);
        else { for (int e = 0; e < 8; ++e) qf[ks][e] = 0; }
      }
      const int nch = (count + 31) >> 5;
      f32x4 o[8];
#pragma unroll
      for (int c = 0; c < 8; ++c) o[c] = (f32x4){0.f, 0.f, 0.f, 0.f};
      float mrun = -1e30f, lsum = 0.f;
      const int qd = (lane & 15) >> 2, pq = lane & 3;
      bf16x8 kr[8];
#define LOADK32(JJ) do { \
        _Pragma("unroll") for (int j = 0; j < 8; ++j) { \
          const int key_ = sel[32 * (JJ) + 4 * j + g4]; \
          kr[j] = *(const bf16x8*)(cn + (tokbase + key_) * 128 + 8 * hd); \
        } } while (0)
      LOADK32(0);
      for (int jj = 0; jj < nch; ++jj) {
#pragma unroll
        for (int j = 0; j < 8; ++j) *(bf16x8*)(reg + (4 * j + g4) * KROW + hd * 16) = kr[j];
        __builtin_amdgcn_sched_barrier(0);
        if (jj + 1 < nch) LOADK32(jj + 1);
        __builtin_amdgcn_sched_barrier(0);
        f32x4 sacc[2];
#pragma unroll
        for (int tt = 0; tt < 2; ++tt) {
          sacc[tt] = (f32x4){0.f, 0.f, 0.f, 0.f};
#pragma unroll
          for (int ks = 0; ks < 4; ++ks) {
            const bf16x8 kfr = *(const bf16x8*)(reg + (16 * tt + hd) * KROW + (32 * ks + 8 * g4) * 2);
            sacc[tt] = __builtin_amdgcn_mfma_f32_16x16x32_bf16(kfr, qf[ks], sacc[tt], 0, 0, 0);
          }
        }
        if (32 * jj + 32 > count) {
#pragma unroll
          for (int tt = 0; tt < 2; ++tt)
#pragma unroll
            for (int i = 0; i < 4; ++i) {
              const int slot = 32 * jj + 16 * tt + 4 * g4 + i;
              if (slot >= count) sacc[tt][i] = -1e30f;
            }
        }
        float mloc = fmaxf(fmaxf(fmaxf(sacc[0][0], sacc[0][1]), fmaxf(sacc[0][2], sacc[0][3])),
                           fmaxf(fmaxf(sacc[1][0], sacc[1][1]), fmaxf(sacc[1][2], sacc[1][3])));
        mloc = fmaxf(mloc, __shfl_xor(mloc, 16));
        mloc = fmaxf(mloc, __shfl_xor(mloc, 32));
        const float mnew = fmaxf(mrun, mloc);
        const float alpha = __builtin_amdgcn_exp2f(mrun - mnew);
        mrun = mnew;
        float pv[8];
#pragma unroll
        for (int tt = 0; tt < 2; ++tt)
#pragma unroll
          for (int i = 0; i < 4; ++i) pv[tt * 4 + i] = __builtin_amdgcn_exp2f(sacc[tt][i] - mnew);
        const float ps = ((pv[0] + pv[1]) + (pv[2] + pv[3])) + ((pv[4] + pv[5]) + (pv[6] + pv[7]));
        bf16x8 pb;
        {
          unsigned* pw = (unsigned*)&pb;
          pw[0] = pack2(pv[0], pv[1]); pw[1] = pack2(pv[2], pv[3]); pw[2] = pack2(pv[4], pv[5]); pw[3] = pack2(pv[6], pv[7]);
        }
        lsum = lsum * alpha + ps;
#pragma unroll
        for (int c = 0; c < 8; ++c) { o[c][0] *= alpha; o[c][1] *= alpha; o[c][2] *= alpha; o[c][3] *= alpha; }
#pragma unroll
        for (int c = 0; c < 8; ++c) {
          const unsigned a_lo = (unsigned)(size_t)(reg) ;
          (void)a_lo;
          s16x4 lo = __builtin_amdgcn_ds_read_tr16_b64_v4i16(
              (s16x4 __attribute__((address_space(3)))*)(reg + (4 * g4 + qd) * KROW + (16 * c + 4 * pq) * 2));
          s16x4 hi = __builtin_amdgcn_ds_read_tr16_b64_v4i16(
              (s16x4 __attribute__((address_space(3)))*)(reg + (16 + 4 * g4 + qd) * KROW + (16 * c + 4 * pq) * 2));
          bf16x8 vf;
          vf[0] = lo[0]; vf[1] = lo[1]; vf[2] = lo[2]; vf[3] = lo[3];
          vf[4] = hi[0]; vf[5] = hi[1]; vf[6] = hi[2]; vf[7] = hi[3];
          o[c] = __builtin_amdgcn_mfma_f32_16x16x32_bf16(vf, pb, o[c], 0, 0, 0);
        }
      }
      lsum += __shfl_xor(lsum, 16);
      lsum += __shfl_xor(lsum, 32);
      const float inv = 1.f / lsum;
      if (hd < 8) {
#pragma unroll
        for (int c = 0; c < 8; ++c) {
          uint2 pk;
          pk.x = pack2(o[c][0] * inv, o[c][1] * inv);
          pk.y = pack2(o[c][2] * inv, o[c][3] * inv);
          *(uint2*)(ql + token * 1024 + hd * 128 + 16 * c + 4 * g4) = pk;
        }
      }
    }
  }
}

__device__ __forceinline__ void run_epilogue(const Params& p, int l, int epi, int b, int row0, int col0, int tid, const float* sC, int ncols) {
  char* ws = p.ws;
  switch (epi) {
    case 0: { EpiInProj e{(u16*)(ws + OFF_QB), (u16*)(ws + OFF_QI), (u16*)(ws + OFF_KI), (u16*)(ws + OFF_SGA), (u16*)(ws + OFF_SGS),
                          (u16*)(ws + OFF_UGM), (u16*)(ws + OFF_CN), (float*)(ws + OFF_WI), p.kvg + l * 128};
              e.run(b, row0, col0, tid, sC, ncols); } break;
    case 1: { EpiQlat e{(u16*)(ws + OFF_QL)}; e.run(b, row0, col0, tid, sC, ncols); } break;
    case 2: { EpiS e{(float*)(ws + OFF_S)}; e.run(b, row0, col0, tid, sC, ncols); } break;
    case 3: { EpiUv e{(const u16*)(ws + OFF_SGA), (u16*)(ws + OFF_XB)}; e.run(b, row0, col0, tid, sC, ncols); } break;
    case 4: { EpiY e{(const u16*)(ws + OFF_UGM), p.d_skip + l * 512, (u16*)(ws + OFF_QB)}; e.run(b, row0, col0, tid, sC, ncols); } break;
    case 5: { EpiGlu e{(const u16*)(ws + OFF_SGS), p.b_glu + l * 1024, (u16*)(ws + OFF_XB)}; e.run(b, row0, col0, tid, sC, ncols); } break;
    default: { EpiOut e{p.x, p.out, (const float*)(ws + OFF_STATS), p.ln_g + (l > 0 ? l - 1 : 0) * DM, p.ln_b + (l > 0 ? l - 1 : 0) * DM, l == 0 ? 1 : 0};
               e.run(b, row0, col0, tid, sC, ncols); } break;
  }
}

__device__ __forceinline__ void make_desc(GemmDesc& d, const Params& p, int l, int op) {
  char* ws = p.ws;
  d.A2 = nullptr; d.a2_bs = 0; d.lda2 = 0; d.ksplit = 1 << 30;
  switch (op) {
    case 0:
      d.A = (const u16*)(ws + OFF_XB); d.lda = DM; d.a_bs = 0;
      d.Bt = (const u16*)(ws + OFF_WINT) + (long)l * NPAD * DM; d.ldb = DM; d.b_bs = 0;
      d.M = NTOK; d.N = NPAD; d.K = DM; d.nbatch = 1; break;
    case 1:
      d.A = (const u16*)(ws + OFF_QB); d.lda = 512; d.a_bs = 64;
      d.Bt = (const u16*)(ws + OFF_WUK) + (long)l * 8 * 128 * 64; d.ldb = 64; d.b_bs = 128 * 64;
      d.M = NTOK; d.N = 128; d.K = 64; d.nbatch = 8; break;
    case 2:
      d.A = (const u16*)(ws + OFF_UGM); d.lda = 256; d.a_bs = (long)NTOK * 16;
      d.Bt = (const u16*)(ws + OFF_OP1) + (long)l * NGRP * 128 * 256; d.ldb = 256; d.b_bs = 128 * 256;
      d.M = NCHUNK; d.N = 128; d.K = 256; d.nbatch = NGRP; break;
    case 3:
      d.A = (const u16*)(ws + OFF_QL); d.lda = 1024; d.a_bs = 256;
      d.Bt = (const u16*)(ws + OFF_WUVP) + (long)l * 4 * 128 * 256; d.ldb = 256; d.b_bs = 128 * 256;
      d.M = NTOK; d.N = 128; d.K = 256; d.nbatch = 4; break;
    case 4:
      d.A = (const u16*)(ws + OFF_UGM); d.lda = 256; d.a_bs = (long)NTOK * 16;
      d.A2 = (const u16*)(ws + OFF_CKV); d.lda2 = 128; d.a2_bs = (long)NCHUNK * 128; d.ksplit = 256;
      d.Bt = (const u16*)(ws + OFF_OP2) + (long)l * NGRP * 256 * 384; d.ldb = 384; d.b_bs = 256 * 384;
      d.M = NCHUNK; d.N = 256; d.K = 384; d.nbatch = NGRP; break;
    case 5:
      d.A = (const u16*)(ws + OFF_QB); d.lda = 512; d.a_bs = 0;
      d.Bt = (const u16*)(ws + OFF_WGLUT) + (long)l * 1024 * 512; d.ldb = 512; d.b_bs = 0;
      d.M = NTOK; d.N = 1024; d.K = 512; d.nbatch = 1; break;
    default:
      d.A = (const u16*)(ws + OFF_XB); d.lda = DM; d.a_bs = 0;
      d.Bt = (const u16*)(ws + OFF_WOUTT) + (long)l * DM * DM; d.ldb = DM; d.b_bs = 0;
      d.M = NTOK; d.N = DM; d.K = DM; d.nbatch = 1; break;
  }
}

__device__ __forceinline__ void run_phase(const Params& p, int ph, char* smem) {
  Ctx cx; cx.tid = threadIdx.x; cx.bid = blockIdx.x; cx.G = gridDim.x;
  OPAQUE_V(cx.tid); OPAQUE_S(cx.bid); OPAQUE_S(cx.G);
  if (ph == 0) { prologue_phase(cx, p, smem); return; }
  const int l = (ph - 1) / 7, s = (ph - 1) % 7;
  int op0 = -1, nops = 0;
  if (s == 0) { op0 = 0; nops = 1; }
  else if (s == 1) { op0 = 1; nops = 2; }
  else if (s == 3) { op0 = 3; nops = 2; }
  else if (s == 4) { op0 = 5; nops = 1; }
  else if (s == 5) { op0 = 6; nops = 1; }
  for (int i = 0; i < nops; ++i) {
    GemmDesc d;
    make_desc(d, p, l, op0 + i);
    gemm_phase(cx, d, op0 + i, p, l, smem);
  }

  if (s == 2) { scan_pass(cx, p, l); attn_phase(cx, p, smem); }
  if (s == 6) layernorm_pass(cx, p, l);
}

__global__ void __launch_bounds__(NTHR, 2) hymba_megakernel(Params p) {
  __shared__ __attribute__((aligned(16))) char smem[SMEM_BYTES];
  cg::grid_group grid = cg::this_grid();
  for (int ph = p.phase_lo; ph < p.phase_hi; ++ph) {
    run_phase(p, ph, smem);
    if (ph + 1 < p.phase_hi) grid.sync();
  }
}

#ifndef MULTI_LAUNCH
#define MULTI_LAUNCH 0
#endif

extern "C" void kernel_launch(void* const* d_in, const int* in_sizes, int n_in, void* d_out, int out_size, void* d_ws, size_t ws_size,
                              hipStream_t stream) {
  static int grid_blocks = 0;
  if (!grid_blocks) {
    int dev = 0, cus = 0, per_cu = 0;
    hipGetDevice(&dev);
    hipDeviceGetAttribute(&cus, hipDeviceAttributeMultiprocessorCount, dev);
    hipOccupancyMaxActiveBlocksPerMultiprocessor(&per_cu, hymba_megakernel, NTHR, 0);
    if (per_cu > 1) per_cu = 1;
    if (per_cu < 1) per_cu = 1;
    grid_blocks = cus * per_cu;
  }
  Params p{};
  p.x = (const float*)d_in[0]; p.w_in = (const float*)d_in[1]; p.kvg = (const float*)d_in[2]; p.w_uk = (const float*)d_in[3];
  p.w_uv = (const float*)d_in[4]; p.log_dt = (const float*)d_in[5]; p.a_re = (const float*)d_in[6]; p.a_im = (const float*)d_in[7];
  p.b_re = (const float*)d_in[8]; p.b_im = (const float*)d_in[9]; p.c_re = (const float*)d_in[10]; p.c_im = (const float*)d_in[11];
  p.d_skip = (const float*)d_in[12]; p.w_glu = (const float*)d_in[13]; p.b_glu = (const float*)d_in[14]; p.w_out = (const float*)d_in[15];
  p.ln_g = (const float*)d_in[16]; p.ln_b = (const float*)d_in[17];
  p.out = (float*)d_out; p.ws = (char*)d_ws;
  const int nph = 1 + 7 * DEPTH;
#if MULTI_LAUNCH
  for (int ph = 0; ph < nph; ++ph) {
    p.phase_lo = ph; p.phase_hi = ph + 1;
    hipLaunchKernelGGL(hymba_megakernel, dim3(grid_blocks), dim3(NTHR), 0, stream, p);
  }
#else
  p.phase_lo = 0; p.phase_hi = nph;
  void* args[] = {&p};
  hipError_t e = hipLaunchCooperativeKernel((void*)hymba_megakernel, dim3(grid_blocks), dim3(NTHR), args, 0, stream);
  if (e != hipSuccess) fprintf(stderr, "cooperative launch failed: %s (grid %d)\n", hipGetErrorString(e), grid_blocks);
#endif
}
```

```cpp
#include <hip/hip_runtime.h>
#include <hip/hip_bf16.h>
#include <hip/hip_cooperative_groups.h>
#include <cstdio>
namespace cg = cooperative_groups;

typedef __attribute__((ext_vector_type(8))) short bf16x8;
typedef __attribute__((ext_vector_type(4))) short s16x4;
typedef __attribute__((ext_vector_type(4))) float f32x4;
typedef __attribute__((ext_vector_type(16))) float f32x16;
typedef unsigned short u16;
typedef unsigned long long u64;

#define NTOK 65536
#define SEQL 4096
#define NBATCH 16
#define DM 1024
#define DIN 2472
#define NPAD 2560
#define DEPTH 4
#define NGRP 32
#define TCH 16
#define NCHUNK 4096
#define ALPHA 1.681792830507429f
#define SMEM_BYTES 151552
#define NTHR 512
#define NWV 8
#define REG_STRIDE 18944
#define KROW 272

#define MiB (1024ull * 1024ull)
#define OFF_XB    (0ull)
#define OFF_QB    (128 * MiB)
#define OFF_CKV   (192 * MiB)
#define OFF_CN    (224 * MiB)
#define OFF_QI    (240 * MiB)
#define OFF_KI    (272 * MiB)
#define OFF_WI    (276 * MiB)
#define OFF_SGA   (278 * MiB)
#define OFF_SGS   (342 * MiB)
#define OFF_UGM   (406 * MiB)
#define OFF_QL    (470 * MiB)
#define OFF_S     (598 * MiB)
#define OFF_STATS (662 * MiB)
#define OFF_WINT  (663 * MiB)
#define OFF_WOUTT (683 * MiB)
#define OFF_WGLUT (691 * MiB)
#define OFF_WUK   (695 * MiB)
#define OFF_WUVP  (696 * MiB)
#define OFF_OP1   (697 * MiB)
#define OFF_OP2   (705 * MiB)
#define OFF_AT    (729 * MiB)

struct Params {
  const float *x, *w_in, *kvg, *w_uk, *w_uv, *log_dt, *a_re, *a_im, *b_re, *b_im, *c_re, *c_im, *d_skip, *w_glu, *b_glu, *w_out, *ln_g, *ln_b;
  float* out;
  char* ws;
  int phase_lo, phase_hi;
};

struct Ctx { int tid, bid, G; };
#define OPAQUE_V(x) asm volatile("" : "+v"(x))
#define OPAQUE_S(x) asm volatile("" : "+s"(x))

__device__ __forceinline__ u16 f2bf(float f) {
  unsigned u = __float_as_uint(f);
  u += 0x7fffu + ((u >> 16) & 1u);
  return (u16)(u >> 16);
}
__device__ __forceinline__ float bf2f(u16 h) { return __uint_as_float(((unsigned)h) << 16); }
typedef __attribute__((ext_vector_type(2))) __bf16 bf16x2_t;
typedef __attribute__((ext_vector_type(2))) float f32x2_t;
__device__ __forceinline__ unsigned pack2(float a, float b) {
  f32x2_t v = {a, b};
  bf16x2_t r = __builtin_convertvector(v, bf16x2_t);
  return *(unsigned*)&r;
}
__device__ __forceinline__ float sigmoid_fast(float v) { return __builtin_amdgcn_rcpf(1.f + __builtin_amdgcn_exp2f(-1.4426950408889634f * v)); }
__device__ __forceinline__ float silu_f(float v) { return v * sigmoid_fast(v); }
__device__ __forceinline__ float gelu_tanh(float y) {
  float t = 0.7978845608028654f * (y + 0.044715f * y * y * y);
  return y * sigmoid_fast(2.f * t);
}

struct GemmDesc {
  const u16* A; const u16* A2; const u16* Bt;
  long a_bs, a2_bs, b_bs;
  int lda, lda2, ldb, ksplit;
  int M, N, K, nbatch;
};

#define LDT 72
#define CLD 260

__device__ __forceinline__ void run_epilogue(const Params& p, int l, int epi, int b, int row0, int col0, int tid, const float* sC, int ncols);

__device__ __forceinline__ void gemm_phase(const Ctx& cx, const GemmDesc& d, int epi, const Params& p, int l, char* smem) {
  const int tid = cx.tid, lane = tid & 63, wid = __builtin_amdgcn_readfirstlane(tid >> 6), wr = wid >> 2, wc = wid & 3;
  const int nM = d.M >> 8, nN = (d.N + 255) >> 8, nk = d.K >> 6;
  const int T = d.nbatch * nM * nN;
  const int G = cx.G, bid = cx.bid;
  int start, step, end;
  if ((G & 7) == 0) {
    int per = G >> 3, chunk = (T + 7) >> 3, xcd = bid & 7;
    start = xcd * chunk + (bid >> 3); step = per; end = min(T, (xcd + 1) * chunk);
  } else { start = bid; step = G; end = T; }
  const int lrow = lane >> 3;
  const int lsrc0 = ((lane & 7) ^ ((lane >> 4) & 7)) * 8;
  const int lsrc1 = ((lane & 7) ^ ((4 + (lane >> 4)) & 7)) * 8;
  const int fsw = (lane >> 1) & 7;
  const int ncols = min(256, d.N);
  const bool active = wc * 64 < ncols;
  for (int t = start; t < end; t += step) {
    const int grp = t / (4 * nN), rem = t - grp * (4 * nN);
    const int n = rem >> 2; const int r = grp * 4 + (rem & 3); const int m = r % nM; const int b = r / nM;
    const u16* Ab = d.A + (long)b * d.a_bs + (long)(m * 256) * d.lda;
    const u16* A2b = d.A2 ? d.A2 + (long)b * d.a2_bs + (long)(m * 256) * d.lda2 : nullptr;
    const u16* Bb = d.Bt + (long)b * d.b_bs + (long)(n * 256) * d.ldb;
    f32x4 acc[8][4];
#pragma unroll
    for (int i = 0; i < 8; ++i)
#pragma unroll
      for (int j = 0; j < 4; ++j) acc[i][j] = (f32x4){0.f, 0.f, 0.f, 0.f};
#define STAGE(kt_, s_) do { \
      const int k0_ = (kt_) * 64; \
      const u16* ap_; long ld_; \
      if (k0_ < d.ksplit) { ap_ = Ab + k0_; ld_ = d.lda; } else { ap_ = A2b + (k0_ - d.ksplit); ld_ = d.lda2; } \
      char* sa_ = smem + (s_) * 65536; \
      _Pragma("unroll") for (int j = 0; j < 4; ++j) { \
        const int g_ = wid * 4 + j;     \
        const int ls_ = (j & 1) ? lsrc1 : lsrc0; \
        __builtin_amdgcn_global_load_lds((const unsigned*)(ap_ + (long)(g_ * 8 + lrow) * ld_ + ls_), \
                                         (unsigned*)(sa_ + g_ * 1024 + lane * 16), 16, 0, 0); \
        const int br_ = (g_ * 8 + lrow) & (ncols - 1);     \
        __builtin_amdgcn_global_load_lds((const unsigned*)(Bb + (long)br_ * d.ldb + k0_ + ls_), \
                                         (unsigned*)(sa_ + 32768 + g_ * 1024 + lane * 16), 16, 0, 0); \
      } \
    } while (0)
    __syncthreads();
    STAGE(0, 0);
    asm volatile("s_waitcnt vmcnt(0)" ::: "memory");
    __builtin_amdgcn_s_barrier();
    const int arow = (wr * 128 + (lane & 15)) * 128, brow = 32768 + (wc * 64 + (lane & 15)) * 128;
    for (int kt = 0; kt < nk; ++kt) {
      const int s = kt & 1;
      if (kt + 1 < nk) STAGE(kt + 1, s ^ 1);
      if (active) {
        const char* sb = smem + s * 65536;
#pragma unroll 1
        for (int kh = 0; kh < 2; ++kh) {
          bf16x8 fa[8], fb[4];
          const int co = (((4 * kh + (lane >> 4)) ^ fsw) * 16);
#pragma unroll
          for (int nt = 0; nt < 4; ++nt) fb[nt] = *(const bf16x8*)(sb + brow + nt * 16 * 128 + co);
          fa[0] = *(const bf16x8*)(sb + arow + co);
          fa[1] = *(const bf16x8*)(sb + arow + 16 * 128 + co);
          __builtin_amdgcn_sched_barrier(0);
          acc[0][0] = __builtin_amdgcn_mfma_f32_16x16x32_bf16(fb[0], fa[0], acc[0][0], 0, 0, 0);
          __builtin_amdgcn_sched_barrier(0);
#pragma unroll
          for (int mt = 2; mt < 8; ++mt) fa[mt] = *(const bf16x8*)(sb + arow + mt * 16 * 128 + co);
          __builtin_amdgcn_sched_barrier(0);
#pragma unroll
          for (int nt = 1; nt < 4; ++nt)
            acc[0][nt] = __builtin_amdgcn_mfma_f32_16x16x32_bf16(fb[nt], fa[0], acc[0][nt], 0, 0, 0);
#pragma unroll
          for (int nt = 0; nt < 4; ++nt)
            acc[1][nt] = __builtin_amdgcn_mfma_f32_16x16x32_bf16(fb[nt], fa[1], acc[1][nt], 0, 0, 0);
          __builtin_amdgcn_sched_barrier(0);
#pragma unroll
          for (int mt = 2; mt < 8; ++mt)
#pragma unroll
            for (int nt = 0; nt < 4; ++nt)
              acc[mt][nt] = __builtin_amdgcn_mfma_f32_16x16x32_bf16(fb[nt], fa[mt], acc[mt][nt], 0, 0, 0);
          __builtin_amdgcn_sched_barrier(0);
        }
      }
      asm volatile("s_waitcnt vmcnt(0)" ::: "memory");
      __builtin_amdgcn_s_barrier();
    }
    float* sC = (float*)smem;
#pragma unroll
    for (int q = 0; q < 2; ++q) {
      if (q) __syncthreads();
      if (active) {
#pragma unroll
        for (int mt2 = 0; mt2 < 4; ++mt2)
#pragma unroll
          for (int nt = 0; nt < 4; ++nt)
            *(f32x4*)(sC + (wr * 64 + mt2 * 16 + (lane & 15)) * CLD + wc * 64 + nt * 16 + 4 * (lane >> 4)) = acc[4 * q + mt2][nt];
      }
      __syncthreads();
      run_epilogue(p, l, epi, b, m * 256 + q * 64, n * 256, tid, sC, ncols);
    }
  }
}

__device__ __forceinline__ uint2 pack4(float4 v) {
  uint2 pk;
  pk.x = pack2(v.x, v.y);
  pk.y = pack2(v.z, v.w);
  return pk;
}
__device__ __forceinline__ float4 unpack4(uint2 u) {
  float4 v;
  v.x = __uint_as_float(u.x << 16); v.y = __uint_as_float(u.x & 0xffff0000u);
  v.z = __uint_as_float(u.y << 16); v.w = __uint_as_float(u.y & 0xffff0000u);
  return v;
}
template <class F>
__device__ __forceinline__ void epi_each(int row0, int col0, int tid, const float* sC, int ncols, const F& f) {
#pragma unroll 2
  for (int j = 0; j < 16; ++j) {
    const int e = tid + NTHR * j;
    const int r = e >> 6, c = (e & 63) * 4;
    if (c < ncols) {
      const float4 v = *(const float4*)(sC + r * CLD + c);
      f(row0 + r + (r & 64), col0 + c, v);
    }
  }
}

struct EpiInProj {
  u16 *qb, *qi, *ki, *sga, *sgs, *ugm; float *ckv, *wi;
  __device__ __forceinline__ void run(int b, int row0, int col0, int tid, const float* sC, int ncols) const {
    const EpiInProj& s = *this;
    epi_each(row0, col0, tid, sC, ncols, [&](int row, int col, float4 v) {
      if (col < 512) *(uint2*)(s.qb + (long)row * 512 + col) = pack4(v);
      else if (col < 640) *(float4*)(s.ckv + (long)row * 128 + (col - 512)) = v;
      else if (col < 896) *(uint2*)(s.qi + (long)row * 256 + (col - 640)) = pack4(v);
      else if (col < 928) *(uint2*)(s.ki + (long)row * 32 + (col - 896)) = pack4(v);
      else if (col < 936) { float4 w = v; w.x *= 0.0625f; w.y *= 0.0625f; w.z *= 0.0625f; w.w *= 0.0625f; *(float4*)(s.wi + (long)row * 8 + (col - 928)) = w; }
      else if (col < 1024) {}
      else if (col < 1536) { float4 w; w.x = silu_f(v.x); w.y = silu_f(v.y); w.z = silu_f(v.z); w.w = silu_f(v.w); *(uint2*)(s.sga + (long)row * 512 + (col - 1024)) = pack4(w); }
      else if (col < 2048) { int cc = col - 1536; *(uint2*)(s.ugm + ((long)(cc >> 4) * NTOK + row) * 16 + (cc & 15)) = pack4(v); }
      else { float4 w; w.x = silu_f(v.x); w.y = silu_f(v.y); w.z = silu_f(v.z); w.w = silu_f(v.w); *(uint2*)(s.sgs + (long)row * 512 + (col - 2048)) = pack4(w); }
    });
  }
};
struct EpiQlat {
  u16* ql;
  __device__ __forceinline__ void run(int b, int row0, int col0, int tid, const float* sC, int ncols) const {
    u16* o = ql;
    epi_each(row0, col0, tid, sC, ncols, [&](int row, int col, float4 v) { *(uint2*)(o + (long)row * 1024 + b * 128 + col) = pack4(v); });
  }
};
struct EpiS {
  float* S;
  __device__ __forceinline__ void run(int b, int row0, int col0, int tid, const float* sC, int ncols) const {
    float* o = S;
    epi_each(row0, col0, tid, sC, ncols, [&](int row, int col, float4 v) { *(float4*)(o + ((long)b * NCHUNK + row) * 128 + col) = v; });
  }
};
struct EpiUv {
  const u16* sga; u16* mixed;
  __device__ __forceinline__ void run(int b, int row0, int col0, int tid, const float* sC, int ncols) const {
    const u16* g = sga; u16* o = mixed;
    epi_each(row0, col0, tid, sC, ncols, [&](int row, int col, float4 v) {
      int c2 = b * 128 + col;
      float4 gv = unpack4(*(const uint2*)(g + (long)row * 512 + c2));
      float4 w; w.x = v.x * gv.x; w.y = v.y * gv.y; w.z = v.z * gv.z; w.w = v.w * gv.w;
      *(uint2*)(o + (long)row * 1024 + c2) = pack4(w);
    });
  }
};
struct EpiY {
  const u16* ugm; const float* dsk; u16* yact;
  __device__ __forceinline__ void run(int b, int row0, int col0, int tid, const float* sC, int ncols) const {
    const u16* u = ugm; const float* dd = dsk; u16* o = yact;
    epi_each(row0, col0, tid, sC, ncols, [&](int row, int col, float4 v) {
      int t = col >> 4, c = col & 15;
      long token = (long)row * TCH + t;
      float4 uv = unpack4(*(const uint2*)(u + ((long)b * NTOK + token) * 16 + c));
      float4 dv = *(const float4*)(dd + b * 16 + c);
      float4 w;
      w.x = gelu_tanh(v.x + dv.x * uv.x); w.y = gelu_tanh(v.y + dv.y * uv.y);
      w.z = gelu_tanh(v.z + dv.z * uv.z); w.w = gelu_tanh(v.w + dv.w * uv.w);
      *(uint2*)(o + token * 512 + b * 16 + c) = pack4(w);
    });
  }
};
struct EpiGlu {
  const u16* sgs; const float* bglu; u16* mixed;
  __device__ __forceinline__ void run(int b, int row0, int col0, int tid, const float* sC, int ncols) const {
#pragma unroll 2
    for (int jj = 0; jj < 8; ++jj) {
      const int e = tid + NTHR * jj;
      const int r = e >> 5, q = e & 31, gi = q >> 3, qq = q & 7;
      const float4 va = *(const float4*)(sC + r * CLD + gi * 64 + qq * 4);
      const float4 ga = *(const float4*)(sC + r * CLD + gi * 64 + 32 + qq * 4);
      const int j = (col0 >> 1) + gi * 32 + qq * 4;
      const long row = row0 + r + (r & 64);
      const float4 bv = *(const float4*)(bglu + j), bg = *(const float4*)(bglu + 512 + j);
      const float4 sg = unpack4(*(const uint2*)(sgs + row * 512 + j));
      float4 w;
      w.x = (va.x + bv.x) * sigmoid_fast(ga.x + bg.x) * sg.x;
      w.y = (va.y + bv.y) * sigmoid_fast(ga.y + bg.y) * sg.y;
      w.z = (va.z + bv.z) * sigmoid_fast(ga.z + bg.z) * sg.z;
      w.w = (va.w + bv.w) * sigmoid_fast(ga.w + bg.w) * sg.w;
      *(uint2*)(mixed + row * 1024 + 512 + j) = pack4(w);
    }
  }
};
struct EpiOut {
  const float* xin; float* z; const float* stats; const float* g; const float* bb; int first;
  __device__ __forceinline__ void run(int b, int row0, int col0, int tid, const float* sC, int ncols) const {
    const EpiOut& s = *this;
    epi_each(row0, col0, tid, sC, ncols, [&](int row, int col, float4 v) {
      long idx = (long)row * 1024 + col;
      float4 xp;
      if (s.first) xp = *(const float4*)(s.xin + idx);
      else {
        float mu = s.stats[2 * row], rs = s.stats[2 * row + 1];
        float4 zo = *(const float4*)(s.z + idx), gv = *(const float4*)(s.g + col), bv = *(const float4*)(s.bb + col);
        xp.x = (zo.x - mu) * rs * gv.x + bv.x; xp.y = (zo.y - mu) * rs * gv.y + bv.y;
        xp.z = (zo.z - mu) * rs * gv.z + bv.z; xp.w = (zo.w - mu) * rs * gv.w + bv.w;
      }
      float4 o; o.x = ALPHA * xp.x + v.x; o.y = ALPHA * xp.y + v.y; o.z = ALPHA * xp.z + v.z; o.w = ALPHA * xp.w + v.w;
      *(float4*)(s.z + idx) = o;
    });
  }
};

template <class CM>
__device__ __forceinline__ void transpose_tile(const Ctx& cx, const float* src, int sld, u16* dst, int dld, int k0, int n0, const CM& colmap, char* smem) {
  float* tile = (float*)smem;
  const int tid = cx.tid;
  __syncthreads();
  for (int e = tid; e < 4096; e += NTHR) {
    int kk = e >> 6, nn = e & 63;
    int sc = colmap(n0 + nn);
    tile[kk * 65 + nn] = sc >= 0 ? src[(long)(k0 + kk) * sld + sc] : 0.f;
  }
  __syncthreads();
  for (int e = tid; e < 4096; e += NTHR) {
    int nn = e >> 6, kk = e & 63;
    dst[(long)(n0 + nn) * dld + k0 + kk] = f2bf(tile[kk * 65 + nn]);
  }
}

__device__ __forceinline__ void ssm_ops(const Ctx& cx, const Params& p, int l, int g, char* smem) {
  float* ap = (float*)smem;
  float* bbm = ap + 17 * 64 * 2;
  float* ccm = bbm + 64 * 16 * 2;
  float* kj = ccm + 16 * 64 * 2;
  const int tid = cx.tid;
  const int lg = l * NGRP + g;
  __syncthreads();
  if (tid < 64) {
    const int pp = tid;
    float dt = expf(p.log_dt[lg]);
    float lr = p.a_re[lg * 64 + pp], li = p.a_im[lg * 64 + pp];
    for (int j = 0; j <= 16; ++j) {
      float mag = expf(lr * dt * (float)j);
      float sn, cs; sincosf(li * dt * (float)j, &sn, &cs);
      ap[(j * 64 + pp) * 2] = mag * cs; ap[(j * 64 + pp) * 2 + 1] = mag * sn;
    }
    float ar = ap[(1 * 64 + pp) * 2], ai = ap[(1 * 64 + pp) * 2 + 1];
    float den = lr * lr + li * li;
    float cr = ((ar - 1.f) * lr + ai * li) / den;
    float ci = (ai * lr - (ar - 1.f) * li) / den;
    for (int c = 0; c < 16; ++c) {
      float br = p.b_re[((long)lg * 64 + pp) * 16 + c], bi = p.b_im[((long)lg * 64 + pp) * 16 + c];
      bbm[(pp * 16 + c) * 2] = cr * br - ci * bi;
      bbm[(pp * 16 + c) * 2 + 1] = cr * bi + ci * br;
    }
    float* at = (float*)(p.ws + OFF_AT) + ((long)lg * 64 + pp) * 2;
    at[0] = ap[(16 * 64 + pp) * 2]; at[1] = ap[(16 * 64 + pp) * 2 + 1];
  }
  for (int e = tid; e < 1024; e += NTHR) {
    ccm[e * 2] = p.c_re[(long)lg * 1024 + e];
    ccm[e * 2 + 1] = p.c_im[(long)lg * 1024 + e];
  }
  __syncthreads();
  for (int e = tid; e < 4096; e += NTHR) {
    int j = e >> 8, cp = (e >> 4) & 15, c = e & 15;
    float s = 0.f;
    for (int pp = 0; pp < 64; ++pp) {
      float c_r = ccm[(cp * 64 + pp) * 2], c_i = ccm[(cp * 64 + pp) * 2 + 1];
      float a_r = ap[(j * 64 + pp) * 2], a_i = ap[(j * 64 + pp) * 2 + 1];
      float er = c_r * a_r - c_i * a_i, ei = c_r * a_i + c_i * a_r;
      s += er * bbm[(pp * 16 + c) * 2] - ei * bbm[(pp * 16 + c) * 2 + 1];
    }
    kj[e] = s;
  }
  __syncthreads();
  u16* op2 = (u16*)(p.ws + OFF_OP2) + (long)lg * 256 * 384;
  for (int e = tid; e < 256 * 384; e += NTHR) {
    int n = e / 384, k = e - n * 384;
    int t = n >> 4, cp = n & 15;
    float v;
    if (k < 256) {
      int s = k >> 4, c = k & 15;
      v = (s <= t) ? kj[((t - s) * 16 + cp) * 16 + c] : 0.f;
    } else {
      int j = k - 256, pp = j & 63;
      float c_r = ccm[(cp * 64 + pp) * 2], c_i = ccm[(cp * 64 + pp) * 2 + 1];
      float a_r = ap[((t + 1) * 64 + pp) * 2], a_i = ap[((t + 1) * 64 + pp) * 2 + 1];
      v = (j < 64) ? (c_r * a_r - c_i * a_i) : -(c_r * a_i + c_i * a_r);
    }
    op2[e] = f2bf(v);
  }
  u16* op1 = (u16*)(p.ws + OFF_OP1) + (long)lg * 128 * 256;
  for (int e = tid; e < 128 * 256; e += NTHR) {
    int j = e >> 8, k = e & 255;
    int pp = j & 63, s = k >> 4, c = k & 15;
    float a_r = ap[((15 - s) * 64 + pp) * 2], a_i = ap[((15 - s) * 64 + pp) * 2 + 1];
    float b_r = bbm[(pp * 16 + c) * 2], b_i = bbm[(pp * 16 + c) * 2 + 1];
    float v = (j < 64) ? (a_r * b_r - a_i * b_i) : (a_r * b_i + a_i * b_r);
    op1[e] = f2bf(v);
  }
}

__device__ __forceinline__ void prologue_phase(const Ctx& cx, const Params& p, char* smem) {
  const int G = cx.G, bid = cx.bid, tid = cx.tid;
  for (int it = bid; it < DEPTH * NGRP; it += G) ssm_ops(cx, p, it / NGRP, it % NGRP, smem);
  for (int it = bid; it < DEPTH * 16 * 40; it += G) {
    int l = it / 640, r = it % 640, kt = r / 40, ntile = r % 40;
    transpose_tile(cx, p.w_in + (long)l * DM * DIN, DIN, (u16*)(p.ws + OFF_WINT) + (long)l * NPAD * DM, DM, kt * 64, ntile * 64,
                   [](int n) { return n < 936 ? n : (n < 1024 ? -1 : n - 88); }, smem);
  }
  for (int it = bid; it < DEPTH * 256; it += G) {
    int l = it >> 8, r = it & 255, kt = r >> 4, ntile = r & 15;
    transpose_tile(cx, p.w_out + (long)l * DM * DM, DM, (u16*)(p.ws + OFF_WOUTT) + (long)l * DM * DM, DM, kt * 64, ntile * 64,
                   [](int n) { return n; }, smem);
  }
  for (int it = bid; it < DEPTH * 128; it += G) {
    int l = it >> 7, r = it & 127, kt = r >> 4, ntile = r & 15;
    transpose_tile(cx, p.w_glu + (long)l * 512 * 1024, 1024, (u16*)(p.ws + OFF_WGLUT) + (long)l * 1024 * 512, 512, kt * 64, ntile * 64,
                   [](int n) { return ((n >> 5) & 1) * 512 + (n >> 6) * 32 + (n & 31); }, smem);
  }
  const long gtid = (long)bid * NTHR + tid, gsz = (long)G * NTHR;
  {
    u16* o = (u16*)(p.ws + OFF_WUK);
    for (long e = gtid; e < (long)DEPTH * 8 * 128 * 64; e += gsz) o[e] = f2bf(0.125f * 1.4426950408889634f * p.w_uk[e]);
  }
  {
    u16* o = (u16*)(p.ws + OFF_WUVP);
    for (long e = gtid; e < (long)DEPTH * 4 * 128 * 256; e += gsz) {
      int k = e & 255, n = (e >> 8) & 127, j = (e >> 15) & 3, l = (int)(e >> 17);
      int hh = n >> 6, dd = n & 63, hh2 = k >> 7, c = k & 127;
      float v = (hh == hh2) ? p.w_uv[(((long)l * 8 + 2 * j + hh) * 128 + c) * 64 + dd] : 0.f;
      o[e] = f2bf(v);
    }
  }
  {
    u16* o = (u16*)(p.ws + OFF_XB);
    const float4* xi = (const float4*)p.x;
    for (long e = gtid; e < (long)NTOK * DM / 4; e += gsz) {
      float4 v = xi[e];
      uint2 pk;
      pk.x = pack2(v.x, v.y);
      pk.y = pack2(v.z, v.w);
      *(uint2*)(o + e * 4) = pk;
    }
  }
}

__device__ __forceinline__ void rmsnorm_pass(const Ctx& cx, const Params& p, int l) {
  const float* ckv = (const float*)(p.ws + OFF_CKV);
  u16* cn = (u16*)(p.ws + OFF_CN);
  const float* g = p.kvg + l * 128;
  const int lane = cx.tid & 63, half = lane >> 5, l32 = lane & 31;
  const long gw = (long)cx.bid * NWV + (cx.tid >> 6), nw = (long)cx.G * NWV;
  const float4 gv = *(const float4*)(g + l32 * 4);
  for (long it = gw; it < NTOK / 2; it += nw) {
    long tok = it * 2 + half;
    float4 v = *(const float4*)(ckv + tok * 128 + l32 * 4);
    float ss = v.x * v.x + v.y * v.y + v.z * v.z + v.w * v.w;
    ss += __shfl_xor(ss, 16); ss += __shfl_xor(ss, 8); ss += __shfl_xor(ss, 4); ss += __shfl_xor(ss, 2); ss += __shfl_xor(ss, 1);
    float rs = rsqrtf(ss * (1.f / 128.f) + 1e-6f);
    uint2 pk;
    pk.x = pack2(v.x * rs * gv.x, v.y * rs * gv.y);
    pk.y = pack2(v.z * rs * gv.z, v.w * rs * gv.w);
    *(uint2*)(cn + tok * 128 + l32 * 4) = pk;
  }
}

__device__ __forceinline__ void layernorm_pass(const Ctx& cx, const Params& p, int l) {
  float* z = p.out;
  float* stats = (float*)(p.ws + OFF_STATS);
  u16* xb = (u16*)(p.ws + OFF_XB);
  const float* g = p.ln_g + l * DM; const float* bb = p.ln_b + l * DM;
  const int lane = cx.tid & 63;
  const long gw = (long)cx.bid * NWV + (cx.tid >> 6), nw = (long)cx.G * NWV;
  float4 gv[4], bv[4];
#pragma unroll
  for (int j = 0; j < 4; ++j) { gv[j] = *(const float4*)(g + j * 256 + lane * 4); bv[j] = *(const float4*)(bb + j * 256 + lane * 4); }
  for (long row = gw; row < NTOK; row += nw) {
    float4 v[4];
    float s = 0.f;
#pragma unroll
    for (int j = 0; j < 4; ++j) { v[j] = *(const float4*)(z + row * DM + j * 256 + lane * 4); s += v[j].x + v[j].y + v[j].z + v[j].w; }
#pragma unroll
    for (int o = 32; o >= 1; o >>= 1) s += __shfl_xor(s, o);
    float mu = s * (1.f / 1024.f);
    float q = 0.f;
#pragma unroll
    for (int j = 0; j < 4; ++j) {
      float a = v[j].x - mu, b = v[j].y - mu, c = v[j].z - mu, d = v[j].w - mu;
      q += a * a + b * b + c * c + d * d;
    }
#pragma unroll
    for (int o = 32; o >= 1; o >>= 1) q += __shfl_xor(q, o);
    float rs = rsqrtf(q * (1.f / 1024.f) + 1e-5f);
    if (l == DEPTH - 1) {
#pragma unroll
      for (int j = 0; j < 4; ++j) {
        float4 o;
        o.x = (v[j].x - mu) * rs * gv[j].x + bv[j].x; o.y = (v[j].y - mu) * rs * gv[j].y + bv[j].y;
        o.z = (v[j].z - mu) * rs * gv[j].z + bv[j].z; o.w = (v[j].w - mu) * rs * gv[j].w + bv[j].w;
        *(float4*)(z + row * DM + j * 256 + lane * 4) = o;
      }
    } else {
      if (lane == 0) { stats[2 * row] = mu; stats[2 * row + 1] = rs; }
#pragma unroll
      for (int j = 0; j < 4; ++j) {
        float a = (v[j].x - mu) * rs * gv[j].x + bv[j].x, b = (v[j].y - mu) * rs * gv[j].y + bv[j].y;
        float c = (v[j].z - mu) * rs * gv[j].z + bv[j].z, d = (v[j].w - mu) * rs * gv[j].w + bv[j].w;
        uint2 pk;
        pk.x = pack2(a, b);
        pk.y = pack2(c, d);
        *(uint2*)(xb + row * DM + j * 256 + lane * 4) = pk;
      }
    }
  }
}

__device__ __forceinline__ void scan_pass(const Ctx& cx, const Params& p, int l) {
  const float* S = (const float*)(p.ws + OFF_S);
  u16* Xin = (u16*)(p.ws + OFF_CKV);
  const int lane = cx.tid & 63;
  const int gw = cx.bid * NWV + (cx.tid >> 6), nw = cx.G * NWV;
  for (int it = gw; it < NBATCH * NGRP; it += nw) {
    int b = it >> 5, g = it & 31;
    const float* at = (const float*)(p.ws + OFF_AT) + ((long)(l * NGRP + g) * 64 + lane) * 2;
    const float ar = at[0], ai = at[1];
    float xr = 0.f, xi = 0.f;
    long row0 = (long)g * NCHUNK + b * 256;
    for (int k0 = 0; k0 < 256; k0 += 32) {
      float sr[32], si[32];
#pragma unroll
      for (int j = 0; j < 32; ++j) { sr[j] = S[(row0 + k0 + j) * 128 + lane]; si[j] = S[(row0 + k0 + j) * 128 + 64 + lane]; }
#pragma unroll
      for (int j = 0; j < 32; ++j) {
        Xin[(row0 + k0 + j) * 128 + lane] = f2bf(xr);
        Xin[(row0 + k0 + j) * 128 + 64 + lane] = f2bf(xi);
        float nr = ar * xr - ai * xi + sr[j];
        float ni = ar * xi + ai * xr + si[j];
        xr = nr; xi = ni;
      }
    }
  }
}

__device__ __forceinline__ unsigned sortable(float f) {
  unsigned u = __float_as_uint(f);
  return u ^ ((unsigned)((int)u >> 31) | 0x80000000u);
}
__device__ __forceinline__ int mbcnt64(u64 m) {
  return __builtin_amdgcn_mbcnt_hi((unsigned)(m >> 32), __builtin_amdgcn_mbcnt_lo((unsigned)m, 0));
}

__device__ __forceinline__ void attn_phase(const Ctx& cx, const Params& p, char* smem) {
  const u16* qi = (const u16*)(p.ws + OFF_QI);
  const u16* ki = (const u16*)(p.ws + OFF_KI);
  const float* wi = (const float*)(p.ws + OFF_WI);
  const u16* cn = (const u16*)(p.ws + OFF_CN);
  u16* ql = (u16*)(p.ws + OFF_QL);
  const int tid = cx.tid, lane = tid & 63, wid = __builtin_amdgcn_readfirstlane(tid >> 6);
  const int hh = lane >> 5;
  const int G = cx.G;
  for (int item = cx.bid; item < (SEQL / 8) * NBATCH; item += G) {
    const int tq = (SEQL / 8 - 1) - (item >> 4), b = item & 15;
    const int t0 = tq * 8;
    const long tokbase = (long)b * SEQL;
    {
      const int r = lane & 31;
      const int qq = 2 * ((r >> 2) & 1) + (r >> 4), head = (r & 3) + 4 * ((r >> 3) & 1);
      const u16* qip = qi + (tokbase + t0 + qq) * 256 + head * 32 + 8 * hh;
      const bf16x8 qa0 = *(const bf16x8*)qip, qa1 = *(const bf16x8*)(qip + 16);
      const bf16x8 qb0 = *(const bf16x8*)(qip + 4 * 256), qb1 = *(const bf16x8*)(qip + 4 * 256 + 16);
      float w0[8], w1[8], w2[8], w3[8];
      {
        const float4* wp = (const float4*)(wi + (tokbase + t0 + 2 * hh) * 8);
        float4 a = wp[0], bq = wp[1], c = wp[2], d = wp[3];
        w0[0] = a.x; w0[1] = a.y; w0[2] = a.z; w0[3] = a.w; w0[4] = bq.x; w0[5] = bq.y; w0[6] = bq.z; w0[7] = bq.w;
        w1[0] = c.x; w1[1] = c.y; w1[2] = c.z; w1[3] = c.w; w1[4] = d.x; w1[5] = d.y; w1[6] = d.z; w1[7] = d.w;
        const float4* wq = (const float4*)(wi + (tokbase + t0 + 4 + 2 * hh) * 8);
        a = wq[0]; bq = wq[1]; c = wq[2]; d = wq[3];
        w2[0] = a.x; w2[1] = a.y; w2[2] = a.z; w2[3] = a.w; w2[4] = bq.x; w2[5] = bq.y; w2[6] = bq.z; w2[7] = bq.w;
        w3[0] = c.x; w3[1] = c.y; w3[2] = c.z; w3[3] = c.w; w3[4] = d.x; w3[5] = d.y; w3[6] = d.z; w3[7] = d.w;
      }
      const int ntiles = ((t0 + 7) >> 5) + 1;
      const int q0 = t0 + 2 * hh;
      unsigned* sc0 = (unsigned*)(smem + (2 * hh) * REG_STRIDE);
      unsigned* sc1 = (unsigned*)(smem + (2 * hh + 1) * REG_STRIDE);
      unsigned* sc2 = (unsigned*)(smem + (4 + 2 * hh) * REG_STRIDE);
      unsigned* sc3 = (unsigned*)(smem + (4 + 2 * hh + 1) * REG_STRIDE);
      __syncthreads();
      bf16x8 nk0, nk1;
      {
        const u16* kp = ki + (tokbase + min(wid, ntiles - 1) * 32 + r) * 32 + 8 * hh;
        nk0 = *(const bf16x8*)kp; nk1 = *(const bf16x8*)(kp + 16);
      }
      for (int tile = wid; tile < ntiles; tile += NWV) {
        const int key = tile * 32 + r;
        const bf16x8 kb0 = nk0, kb1 = nk1;
        {
          const u16* kp = ki + (tokbase + min(tile + NWV, ntiles - 1) * 32 + r) * 32 + 8 * hh;
          nk0 = *(const bf16x8*)kp; nk1 = *(const bf16x8*)(kp + 16);
        }
        f32x16 acc, acd;
#pragma unroll
        for (int e = 0; e < 16; ++e) { acc[e] = 0.f; acd[e] = 0.f; }
        acc = __builtin_amdgcn_mfma_f32_32x32x16_bf16(qa0, kb0, acc, 0, 0, 0);
        acd = __builtin_amdgcn_mfma_f32_32x32x16_bf16(qb0, kb0, acd, 0, 0, 0);
        acc = __builtin_amdgcn_mfma_f32_32x32x16_bf16(qa1, kb1, acc, 0, 0, 0);
        acd = __builtin_amdgcn_mfma_f32_32x32x16_bf16(qb1, kb1, acd, 0, 0, 0);
        float s0 = 0.f, s1 = 0.f, s2 = 0.f, s3 = 0.f;
#pragma unroll
        for (int e = 0; e < 8; ++e) {
          s0 += w0[e] * fmaxf(acc[e], 0.f); s1 += w1[e] * fmaxf(acc[8 + e], 0.f);
          s2 += w2[e] * fmaxf(acd[e], 0.f); s3 += w3[e] * fmaxf(acd[8 + e], 0.f);
        }
        sc0[key] = (key <= q0) ? sortable(s0) : 0u;
        sc1[key] = (key <= q0 + 1) ? sortable(s1) : 0u;
        sc2[key] = (key <= q0 + 4) ? sortable(s2) : 0u;
        sc3[key] = (key <= q0 + 5) ? sortable(s3) : 0u;
      }
      __syncthreads();
    }
    const int t = t0 + wid;
    char* reg = smem + wid * REG_STRIDE;
    const unsigned* sc = (const unsigned*)reg;
    u16* sel = (u16*)(reg + 18432);
    const int nvalid = t + 1;
    int count;
    if (nvalid <= 256) {
      count = nvalid;
      for (int i = lane; i < 256; i += 64) sel[i] = (u16)(i < nvalid ? i : 0);
    } else {
      count = 256;
      unsigned v[64];
#pragma unroll
      for (int i = 0; i < 64; ++i) { int key = i * 64 + lane; v[i] = (key < nvalid) ? sc[key] : 0u; }
      const int ni = (nvalid + 63) >> 6;
#define CNT_GE(THR, CNT) do { \
        int c_ = 0; \
        _Pragma("unroll") for (int gq = 0; gq < 4; ++gq) { \
          if (gq * 16 < ni) { \
            _Pragma("unroll") for (int j = 0; j < 16; ++j) c_ += __builtin_popcountll(__ballot(v[gq * 16 + j] >= (THR))); \
          } \
        } \
        CNT = c_; } while (0)
      unsigned vmax = 0u;
#pragma unroll
      for (int i = 0; i < 64; ++i) vmax = max(vmax, v[i]);
#pragma unroll
      for (int o = 32; o >= 1; o >>= 1) vmax = max(vmax, (unsigned)__shfl_xor((int)vmax, o));
      vmax = (unsigned)__builtin_amdgcn_readfirstlane((int)vmax);
      unsigned lo = 0u, hi = vmax + 1u;
      int clo = 4096, chi = 0;
      bool positive = false;
      {
        int c0; CNT_GE(0x80000000u, c0);
        if (c0 >= 256) { lo = 0x80000000u; clo = c0; positive = true; }
        else { hi = 0x80000000u; chi = c0; }
      }
      while (clo != 256 && clo - chi > 128 && hi - lo > 1u) {
        unsigned mid = lo + ((hi - lo) >> 1);
        if (positive) {
          const float fm = 0.5f * (__uint_as_float(lo & 0x7fffffffu) + __uint_as_float(hi & 0x7fffffffu));
          const unsigned m2 = __float_as_uint(fm) | 0x80000000u;
          if (m2 > lo && m2 < hi) mid = m2;
        }
        int cnt; CNT_GE(mid, cnt);
        if (cnt >= 256) { lo = mid; clo = cnt; } else { hi = mid; chi = cnt; }
      }
      if (clo <= 384) {
        unsigned* dval = (unsigned*)(reg + 8192);
        u16* dkey = (u16*)(reg + 8192 + 1536);
        {
          int base = 0;
#pragma unroll
          for (int gq = 0; gq < 4; ++gq) {
            if (gq * 16 < ni) {
#pragma unroll
              for (int j = 0; j < 16; ++j) {
                const int i = gq * 16 + j;
                const bool in = v[i] >= lo;
                const u64 m = __ballot(in);
                if (in) { const int pos = base + mbcnt64(m); dval[pos] = v[i]; dkey[pos] = (u16)(i * 64 + lane); }
                base += __builtin_popcountll(m);
              }
            }
          }
        }
        unsigned dv[6]; int dk[6];
#pragma unroll
        for (int j = 0; j < 6; ++j) {
          const int idx = j * 64 + lane;
          dv[j] = (idx < clo) ? dval[idx] : 0u;
          dk[j] = (idx < clo) ? (int)dkey[idx] : 0;
        }
        while (clo != 256 && hi - lo > 1u) {
          const unsigned mid = lo + ((hi - lo) >> 1);
          int cnt = 0;
#pragma unroll
          for (int j = 0; j < 6; ++j) cnt += __builtin_popcountll(__ballot(dv[j] >= mid));
          if (cnt >= 256) { lo = mid; clo = cnt; } else { hi = mid; chi = cnt; }
        }
        int base = 0, eqleft = (clo == 256) ? 512 : 256 - chi;
#pragma unroll
        for (int j = 0; j < 6; ++j) {
          const bool gt = dv[j] > lo, eq = dv[j] == lo;
          const u64 meq = __ballot(eq);
          const bool take = gt || (eq && mbcnt64(meq) < eqleft);
          const u64 mt = __ballot(take);
          if (take) sel[base + mbcnt64(mt)] = (u16)dk[j];
          base += __builtin_popcountll(mt);
          eqleft -= min((int)__builtin_popcountll(meq), eqleft);
        }
      } else {
        int base = 0, eqleft = 256 - chi;
#pragma unroll
        for (int gq = 0; gq < 4; ++gq) {
          if (gq * 16 < ni) {
#pragma unroll
            for (int j = 0; j < 16; ++j) {
              const int i = gq * 16 + j;
              const bool gt = v[i] > lo, eq = v[i] == lo;
              const u64 meq = __ballot(eq);
              const bool take = gt || (eq && mbcnt64(meq) < eqleft);
              const u64 mt = __ballot(take);
              if (take) sel[base + mbcnt64(mt)] = (u16)(i * 64 + lane);
              base += __builtin_popcountll(mt);
              eqleft -= min((int)__builtin_popcountll(meq), eqleft);
              if ((j & 3) == 3) __builtin_amdgcn_sched_barrier(0);
            }
          }
        }
      }
    }
    {
      const long token = tokbase + t;
      const int hd = lane & 15, g4 = lane >> 4;
      bf16x8 qf[4];
#pragma unroll
      for (int ks = 0; ks < 4; ++ks) {
        if (hd < 8) qf[ks] = *(const bf16x8*)(ql + token * 1024 + hd * 128 + 32 * ks + 8 * g4);
        else { for (int e = 0; e < 8; ++e) qf[ks][e] = 0; }
      }
      const int nch = (count + 31) >> 5;
      f32x4 o[8];
#pragma unroll
      for (int c = 0; c < 8; ++c) o[c] = (f32x4){0.f, 0.f, 0.f, 0.f};
      float mrun = -1e30f, lsum = 0.f;
      const int qd = (lane & 15) >> 2, pq = lane & 3;
      bf16x8 kr[8];
#define LOADK32(JJ) do { \
        _Pragma("unroll") for (int j = 0; j < 8; ++j) { \
          const int key_ = sel[32 * (JJ) + 4 * j + g4]; \
          kr[j] = *(const bf16x8*)(cn + (tokbase + key_) * 128 + 8 * hd); \
        } } while (0)
      LOADK32(0);
      for (int jj = 0; jj < nch; ++jj) {
#pragma unroll
        for (int j = 0; j < 8; ++j) *(bf16x8*)(reg + (4 * j + g4) * KROW + hd * 16) = kr[j];
        __builtin_amdgcn_sched_barrier(0);
        if (jj + 1 < nch) LOADK32(jj + 1);
        __builtin_amdgcn_sched_barrier(0);
        f32x4 sacc[2];
#pragma unroll
        for (int tt = 0; tt < 2; ++tt) {
          sacc[tt] = (f32x4){0.f, 0.f, 0.f, 0.f};
#pragma unroll
          for (int ks = 0; ks < 4; ++ks) {
            const bf16x8 kfr = *(const bf16x8*)(reg + (16 * tt + hd) * KROW + (32 * ks + 8 * g4) * 2);
            sacc[tt] = __builtin_amdgcn_mfma_f32_16x16x32_bf16(kfr, qf[ks], sacc[tt], 0, 0, 0);
          }
        }
        if (32 * jj + 32 > count) {
#pragma unroll
          for (int tt = 0; tt < 2; ++tt)
#pragma unroll
            for (int i = 0; i < 4; ++i) {
              const int slot = 32 * jj + 16 * tt + 4 * g4 + i;
              if (slot >= count) sacc[tt][i] = -1e30f;
            }
        }
        float mloc = fmaxf(fmaxf(fmaxf(sacc[0][0], sacc[0][1]), fmaxf(sacc[0][2], sacc[0][3])),
                           fmaxf(fmaxf(sacc[1][0], sacc[1][1]), fmaxf(sacc[1][2], sacc[1][3])));
        mloc = fmaxf(mloc, __shfl_xor(mloc, 16));
        mloc = fmaxf(mloc, __shfl_xor(mloc, 32));
        const float mnew = fmaxf(mrun, mloc);
        const float alpha = __builtin_amdgcn_exp2f(mrun - mnew);
        mrun = mnew;
        float pv[8];
#pragma unroll
        for (int tt = 0; tt < 2; ++tt)
#pragma unroll
          for (int i = 0; i < 4; ++i) pv[tt * 4 + i] = __builtin_amdgcn_exp2f(sacc[tt][i] - mnew);
        const float ps = ((pv[0] + pv[1]) + (pv[2] + pv[3])) + ((pv[4] + pv[5]) + (pv[6] + pv[7]));
        bf16x8 pb;
        {
          unsigned* pw = (unsigned*)&pb;
          pw[0] = pack2(pv[0], pv[1]); pw[1] = pack2(pv[2], pv[3]); pw[2] = pack2(pv[4], pv[5]); pw[3] = pack2(pv[6], pv[7]);
        }
        lsum = lsum * alpha + ps;
#pragma unroll
        for (int c = 0; c < 8; ++c) { o[c][0] *= alpha; o[c][1] *= alpha; o[c][2] *= alpha; o[c][3] *= alpha; }
#pragma unroll
        for (int c = 0; c < 8; ++c) {
          const unsigned a_lo = (unsigned)(size_t)(reg) ;
          (void)a_lo;
          s16x4 lo = __builtin_amdgcn_ds_read_tr16_b64_v4i16(
              (s16x4 __attribute__((address_space(3)))*)(reg + (4 * g4 + qd) * KROW + (16 * c + 4 * pq) * 2));
          s16x4 hi = __builtin_amdgcn_ds_read_tr16_b64_v4i16(
              (s16x4 __attribute__((address_space(3)))*)(reg + (16 + 4 * g4 + qd) * KROW + (16 * c + 4 * pq) * 2));
          bf16x8 vf;
          vf[0] = lo[0]; vf[1] = lo[1]; vf[2] = lo[2]; vf[3] = lo[3];
          vf[4] = hi[0]; vf[5] = hi[1]; vf[6] = hi[2]; vf[7] = hi[3];
          o[c] = __builtin_amdgcn_mfma_f32_16x16x32_bf16(vf, pb, o[c], 0, 0, 0);
        }
      }
      lsum += __shfl_xor(lsum, 16);
      lsum += __shfl_xor(lsum, 32);
      const float inv = 1.f / lsum;
      if (hd < 8) {
#pragma unroll
        for (int c = 0; c < 8; ++c) {
          uint2 pk;
          pk.x = pack2(o[c][0] * inv, o[c][1] * inv);
          pk.y = pack2(o[c][2] * inv, o[c][3] * inv);
          *(uint2*)(ql + token * 1024 + hd * 128 + 16 * c + 4 * g4) = pk;
        }
      }
    }
  }
}

__device__ __forceinline__ void run_epilogue(const Params& p, int l, int epi, int b, int row0, int col0, int tid, const float* sC, int ncols) {
  char* ws = p.ws;
  switch (epi) {
    case 0: { EpiInProj e{(u16*)(ws + OFF_QB), (u16*)(ws + OFF_QI), (u16*)(ws + OFF_KI), (u16*)(ws + OFF_SGA), (u16*)(ws + OFF_SGS),
                          (u16*)(ws + OFF_UGM), (float*)(ws + OFF_CKV), (float*)(ws + OFF_WI)};
              e.run(b, row0, col0, tid, sC, ncols); } break;
    case 1: { EpiQlat e{(u16*)(ws + OFF_QL)}; e.run(b, row0, col0, tid, sC, ncols); } break;
    case 2: { EpiS e{(float*)(ws + OFF_S)}; e.run(b, row0, col0, tid, sC, ncols); } break;
    case 3: { EpiUv e{(const u16*)(ws + OFF_SGA), (u16*)(ws + OFF_XB)}; e.run(b, row0, col0, tid, sC, ncols); } break;
    case 4: { EpiY e{(const u16*)(ws + OFF_UGM), p.d_skip + l * 512, (u16*)(ws + OFF_QB)}; e.run(b, row0, col0, tid, sC, ncols); } break;
    case 5: { EpiGlu e{(const u16*)(ws + OFF_SGS), p.b_glu + l * 1024, (u16*)(ws + OFF_XB)}; e.run(b, row0, col0, tid, sC, ncols); } break;
    default: { EpiOut e{p.x, p.out, (const float*)(ws + OFF_STATS), p.ln_g + (l > 0 ? l - 1 : 0) * DM, p.ln_b + (l > 0 ? l - 1 : 0) * DM, l == 0 ? 1 : 0};
               e.run(b, row0, col0, tid, sC, ncols); } break;
  }
}

__device__ __forceinline__ void make_desc(GemmDesc& d, const Params& p, int l, int op) {
  char* ws = p.ws;
  d.A2 = nullptr; d.a2_bs = 0; d.lda2 = 0; d.ksplit = 1 << 30;
  switch (op) {
    case 0:
      d.A = (const u16*)(ws + OFF_XB); d.lda = DM; d.a_bs = 0;
      d.Bt = (const u16*)(ws + OFF_WINT) + (long)l * NPAD * DM; d.ldb = DM; d.b_bs = 0;
      d.M = NTOK; d.N = NPAD; d.K = DM; d.nbatch = 1; break;
    case 1:
      d.A = (const u16*)(ws + OFF_QB); d.lda = 512; d.a_bs = 64;
      d.Bt = (const u16*)(ws + OFF_WUK) + (long)l * 8 * 128 * 64; d.ldb = 64; d.b_bs = 128 * 64;
      d.M = NTOK; d.N = 128; d.K = 64; d.nbatch = 8; break;
    case 2:
      d.A = (const u16*)(ws + OFF_UGM); d.lda = 256; d.a_bs = (long)NTOK * 16;
      d.Bt = (const u16*)(ws + OFF_OP1) + (long)l * NGRP * 128 * 256; d.ldb = 256; d.b_bs = 128 * 256;
      d.M = NCHUNK; d.N = 128; d.K = 256; d.nbatch = NGRP; break;
    case 3:
      d.A = (const u16*)(ws + OFF_QL); d.lda = 1024; d.a_bs = 256;
      d.Bt = (const u16*)(ws + OFF_WUVP) + (long)l * 4 * 128 * 256; d.ldb = 256; d.b_bs = 128 * 256;
      d.M = NTOK; d.N = 128; d.K = 256; d.nbatch = 4; break;
    case 4:
      d.A = (const u16*)(ws + OFF_UGM); d.lda = 256; d.a_bs = (long)NTOK * 16;
      d.A2 = (const u16*)(ws + OFF_CKV); d.lda2 = 128; d.a2_bs = (long)NCHUNK * 128; d.ksplit = 256;
      d.Bt = (const u16*)(ws + OFF_OP2) + (long)l * NGRP * 256 * 384; d.ldb = 384; d.b_bs = 256 * 384;
      d.M = NCHUNK; d.N = 256; d.K = 384; d.nbatch = NGRP; break;
    case 5:
      d.A = (const u16*)(ws + OFF_QB); d.lda = 512; d.a_bs = 0;
      d.Bt = (const u16*)(ws + OFF_WGLUT) + (long)l * 1024 * 512; d.ldb = 512; d.b_bs = 0;
      d.M = NTOK; d.N = 1024; d.K = 512; d.nbatch = 1; break;
    default:
      d.A = (const u16*)(ws + OFF_XB); d.lda = DM; d.a_bs = 0;
      d.Bt = (const u16*)(ws + OFF_WOUTT) + (long)l * DM * DM; d.ldb = DM; d.b_bs = 0;
      d.M = NTOK; d.N = DM; d.K = DM; d.nbatch = 1; break;
  }
}

__device__ __forceinline__ void run_phase(const Params& p, int ph, char* smem) {
  Ctx cx; cx.tid = threadIdx.x; cx.bid = blockIdx.x; cx.G = gridDim.x;
  OPAQUE_V(cx.tid); OPAQUE_S(cx.bid); OPAQUE_S(cx.G);
  if (ph == 0) { prologue_phase(cx, p, smem); return; }
  const int l = (ph - 1) / 7, s = (ph - 1) % 7;
  int op0 = -1, nops = 0;
  if (s == 0) { op0 = 0; nops = 1; }
  else if (s == 1) { op0 = 1; nops = 2; }
  else if (s == 3) { op0 = 3; nops = 2; }
  else if (s == 4) { op0 = 5; nops = 1; }
  else if (s == 5) { op0 = 6; nops = 1; }
  for (int i = 0; i < nops; ++i) {
    GemmDesc d;
    make_desc(d, p, l, op0 + i);
    gemm_phase(cx, d, op0 + i, p, l, smem);
  }
  if (s == 1) rmsnorm_pass(cx, p, l);
  if (s == 2) { scan_pass(cx, p, l); attn_phase(cx, p, smem); }
  if (s == 6) layernorm_pass(cx, p, l);
}

__global__ void __launch_bounds__(NTHR, 2) hymba_megakernel(Params p) {
  __shared__ __attribute__((aligned(16))) char smem[SMEM_BYTES];
  cg::grid_group grid = cg::this_grid();
  for (int ph = p.phase_lo; ph < p.phase_hi; ++ph) {
    run_phase(p, ph, smem);
    if (ph + 1 < p.phase_hi) grid.sync();
  }
}

#ifndef MULTI_LAUNCH
#define MULTI_LAUNCH 0
#endif

extern "C" void kernel_launch(void* const* d_in, const int* in_sizes, int n_in, void* d_out, int out_size, void* d_ws, size_t ws_size,
                              hipStream_t stream) {
  static int grid_blocks = 0;
  if (!grid_blocks) {
    int dev = 0, cus = 0, per_cu = 0;
    hipGetDevice(&dev);
    hipDeviceGetAttribute(&cus, hipDeviceAttributeMultiprocessorCount, dev);
    hipOccupancyMaxActiveBlocksPerMultiprocessor(&per_cu, hymba_megakernel, NTHR, 0);
    if (per_cu > 1) per_cu = 1;
    if (per_cu < 1) per_cu = 1;
    grid_blocks = cus * per_cu;
  }
  Params p{};
  p.x = (const float*)d_in[0]; p.w_in = (const float*)d_in[1]; p.kvg = (const float*)d_in[2]; p.w_uk = (const float*)d_in[3];
  p.w_uv = (const float*)d_in[4]; p.log_dt = (const float*)d_in[5]; p.a_re = (const float*)d_in[6]; p.a_im = (const float*)d_in[7];
  p.b_re = (const float*)d_in[8]; p.b_im = (const float*)d_in[9]; p.c_re = (const float*)d_in[10]; p.c_im = (const float*)d_in[11];
  p.d_skip = (const float*)d_in[12]; p.w_glu = (const float*)d_in[13]; p.b_glu = (const float*)d_in[14]; p.w_out = (const float*)d_in[15];
  p.ln_g = (const float*)d_in[16]; p.ln_b = (const float*)d_in[17];
  p.out = (float*)d_out; p.ws = (char*)d_ws;
  const int nph = 1 + 7 * DEPTH;
#if MULTI_LAUNCH
  for (int ph = 0; ph < nph; ++ph) {
    p.phase_lo = ph; p.phase_hi = ph + 1;
    hipLaunchKernelGGL(hymba_megakernel, dim3(grid_blocks), dim3(NTHR), 0, stream, p);
  }
#else
  p.phase_lo = 0; p.phase_hi = nph;
  void* args[] = {&p};
  hipError_t e = hipLaunchCooperativeKernel((void*)hymba_megakernel, dim3(grid_blocks), dim3(NTHR), args, 0, stream);
  if (e != hipSuccess) fprintf(stderr, "cooperative launch failed: %s (grid %d)\n", hipGetErrorString(e), grid_blocks);
#endif
}
```

```cpp
#include <hip/hip_runtime.h>
#include <hip/hip_bf16.h>
#include <hip/hip_cooperative_groups.h>
#include <cstdio>
namespace cg = cooperative_groups;

typedef __attribute__((ext_vector_type(8))) short bf16x8;
typedef __attribute__((ext_vector_type(4))) short s16x4;
typedef __attribute__((ext_vector_type(4))) float f32x4;
typedef __attribute__((ext_vector_type(16))) float f32x16;
typedef unsigned short u16;
typedef unsigned long long u64;

#define NTOK 65536
#define SEQL 4096
#define NBATCH 16
#define DM 1024
#define DIN 2472
#define NPAD 2560
#define DEPTH 4
#define NGRP 32
#define TCH 16
#define NCHUNK 4096
#define ALPHA 1.681792830507429f
#define SMEM_BYTES 151552
#define NTHR 512
#define NWV 8
#define REG_STRIDE 18944
#define KROW 272

#define MiB (1024ull * 1024ull)
#define OFF_XB    (0ull)
#define OFF_QB    (128 * MiB)
#define OFF_CKV   (192 * MiB)
#define OFF_CN    (224 * MiB)
#define OFF_QI    (240 * MiB)
#define OFF_KI    (272 * MiB)
#define OFF_WI    (276 * MiB)
#define OFF_SGA   (278 * MiB)
#define OFF_SGS   (342 * MiB)
#define OFF_UGM   (406 * MiB)
#define OFF_QL    (470 * MiB)
#define OFF_S     (598 * MiB)
#define OFF_STATS (662 * MiB)
#define OFF_WINT  (663 * MiB)
#define OFF_WOUTT (683 * MiB)
#define OFF_WGLUT (691 * MiB)
#define OFF_WUK   (695 * MiB)
#define OFF_WUVP  (696 * MiB)
#define OFF_OP1   (697 * MiB)
#define OFF_OP2   (705 * MiB)
#define OFF_AT    (729 * MiB)

struct Params {
  const float *x, *w_in, *kvg, *w_uk, *w_uv, *log_dt, *a_re, *a_im, *b_re, *b_im, *c_re, *c_im, *d_skip, *w_glu, *b_glu, *w_out, *ln_g, *ln_b;
  float* out;
  char* ws;
  int phase_lo, phase_hi;
};

struct Ctx { int tid, bid, G; };
#define OPAQUE_V(x) asm volatile("" : "+v"(x))
#define OPAQUE_S(x) asm volatile("" : "+s"(x))

__device__ __forceinline__ u16 f2bf(float f) {
  unsigned u = __float_as_uint(f);
  u += 0x7fffu + ((u >> 16) & 1u);
  return (u16)(u >> 16);
}
__device__ __forceinline__ float bf2f(u16 h) { return __uint_as_float(((unsigned)h) << 16); }
typedef __attribute__((ext_vector_type(2))) __bf16 bf16x2_t;
typedef __attribute__((ext_vector_type(2))) float f32x2_t;
__device__ __forceinline__ unsigned pack2(float a, float b) {
  f32x2_t v = {a, b};
  bf16x2_t r = __builtin_convertvector(v, bf16x2_t);
  return *(unsigned*)&r;
}
__device__ __forceinline__ float sigmoid_fast(float v) { return __builtin_amdgcn_rcpf(1.f + __builtin_amdgcn_exp2f(-1.4426950408889634f * v)); }
__device__ __forceinline__ float silu_f(float v) { return v * sigmoid_fast(v); }
__device__ __forceinline__ float gelu_tanh(float y) {
  float t = 0.7978845608028654f * (y + 0.044715f * y * y * y);
  return y * sigmoid_fast(2.f * t);
}

struct GemmDesc {
  const u16* A; const u16* A2; const u16* Bt;
  long a_bs, a2_bs, b_bs;
  int lda, lda2, ldb, ksplit;
  int M, N, K, nbatch;
};

#define LDT 72
#define CLD 260

__device__ __forceinline__ void run_epilogue(const Params& p, int l, int epi, int b, int row0, int col0, int tid, const float* sC, int ncols);

__device__ __forceinline__ void gemm_phase(const Ctx& cx, const GemmDesc& d, int epi, const Params& p, int l, char* smem) {
  const int tid = cx.tid, lane = tid & 63, wid = __builtin_amdgcn_readfirstlane(tid >> 6), wr = wid >> 2, wc = wid & 3;
  const int nM = d.M >> 8, nN = (d.N + 255) >> 8, nk = d.K >> 6;
  const int T = d.nbatch * nM * nN;
  const int G = cx.G, bid = cx.bid;
  int start, step, end;
  if ((G & 7) == 0) {
    int per = G >> 3, chunk = (T + 7) >> 3, xcd = bid & 7;
    start = xcd * chunk + (bid >> 3); step = per; end = min(T, (xcd + 1) * chunk);
  } else { start = bid; step = G; end = T; }
  const int lrow = lane >> 3;
  const int lsrc0 = ((lane & 7) ^ ((lane >> 4) & 7)) * 8;
  const int lsrc1 = ((lane & 7) ^ ((4 + (lane >> 4)) & 7)) * 8;
  const int fsw = (lane >> 1) & 7;
  const int ncols = min(256, d.N);
  const bool active = wc * 64 < ncols;
  for (int t = start; t < end; t += step) {
    const int grp = t / (4 * nN), rem = t - grp * (4 * nN);
    const int n = rem >> 2; const int r = grp * 4 + (rem & 3); const int m = r % nM; const int b = r / nM;
    const u16* Ab = d.A + (long)b * d.a_bs + (long)(m * 256) * d.lda;
    const u16* A2b = d.A2 ? d.A2 + (long)b * d.a2_bs + (long)(m * 256) * d.lda2 : nullptr;
    const u16* Bb = d.Bt + (long)b * d.b_bs + (long)(n * 256) * d.ldb;
    f32x4 acc[8][4];
#pragma unroll
    for (int i = 0; i < 8; ++i)
#pragma unroll
      for (int j = 0; j < 4; ++j) acc[i][j] = (f32x4){0.f, 0.f, 0.f, 0.f};
#define STAGE(kt_, s_) do { \
      const int k0_ = (kt_) * 64; \
      const u16* ap_; long ld_; \
      if (k0_ < d.ksplit) { ap_ = Ab + k0_; ld_ = d.lda; } else { ap_ = A2b + (k0_ - d.ksplit); ld_ = d.lda2; } \
      char* sa_ = smem + (s_) * 65536; \
      _Pragma("unroll") for (int j = 0; j < 4; ++j) { \
        const int g_ = wid * 4 + j;     \
        const int ls_ = (j & 1) ? lsrc1 : lsrc0; \
        __builtin_amdgcn_global_load_lds((const unsigned*)(ap_ + (long)(g_ * 8 + lrow) * ld_ + ls_), \
                                         (unsigned*)(sa_ + g_ * 1024 + lane * 16), 16, 0, 0); \
        const int br_ = (g_ * 8 + lrow) & (ncols - 1);     \
        __builtin_amdgcn_global_load_lds((const unsigned*)(Bb + (long)br_ * d.ldb + k0_ + ls_), \
                                         (unsigned*)(sa_ + 32768 + g_ * 1024 + lane * 16), 16, 0, 0); \
      } \
    } while (0)
    __syncthreads();
    STAGE(0, 0);
    asm volatile("s_waitcnt vmcnt(0)" ::: "memory");
    __builtin_amdgcn_s_barrier();
    const int arow = (wr * 128 + (lane & 15)) * 128, brow = 32768 + (wc * 64 + (lane & 15)) * 128;
    for (int kt = 0; kt < nk; ++kt) {
      const int s = kt & 1;
      if (kt + 1 < nk) STAGE(kt + 1, s ^ 1);
      if (active) {
        const char* sb = smem + s * 65536;
#pragma unroll 1
        for (int kh = 0; kh < 2; ++kh) {
          bf16x8 fa[8], fb[4];
          const int co = (((4 * kh + (lane >> 4)) ^ fsw) * 16);
#pragma unroll
          for (int nt = 0; nt < 4; ++nt) fb[nt] = *(const bf16x8*)(sb + brow + nt * 16 * 128 + co);
          fa[0] = *(const bf16x8*)(sb + arow + co);
          fa[1] = *(const bf16x8*)(sb + arow + 16 * 128 + co);
          __builtin_amdgcn_sched_barrier(0);
          acc[0][0] = __builtin_amdgcn_mfma_f32_16x16x32_bf16(fb[0], fa[0], acc[0][0], 0, 0, 0);
          __builtin_amdgcn_sched_barrier(0);
#pragma unroll
          for (int mt = 2; mt < 8; ++mt) fa[mt] = *(const bf16x8*)(sb + arow + mt * 16 * 128 + co);
          __builtin_amdgcn_sched_barrier(0);
#pragma unroll
          for (int nt = 1; nt < 4; ++nt)
            acc[0][nt] = __builtin_amdgcn_mfma_f32_16x16x32_bf16(fb[nt], fa[0], acc[0][nt], 0, 0, 0);
#pragma unroll
          for (int nt = 0; nt < 4; ++nt)
            acc[1][nt] = __builtin_amdgcn_mfma_f32_16x16x32_bf16(fb[nt], fa[1], acc[1][nt], 0, 0, 0);
          __builtin_amdgcn_sched_barrier(0);
#pragma unroll
          for (int mt = 2; mt < 8; ++mt)
#pragma unroll
            for (int nt = 0; nt < 4; ++nt)
              acc[mt][nt] = __builtin_amdgcn_mfma_f32_16x16x32_bf16(fb[nt], fa[mt], acc[mt][nt], 0, 0, 0);
          __builtin_amdgcn_sched_barrier(0);
        }
      }
      asm volatile("s_waitcnt vmcnt(0)" ::: "memory");
      __builtin_amdgcn_s_barrier();
    }
    float* sC = (float*)smem;
#pragma unroll
    for (int q = 0; q < 2; ++q) {
      if (q) __syncthreads();
      if (active) {
#pragma unroll
        for (int mt2 = 0; mt2 < 4; ++mt2)
#pragma unroll
          for (int nt = 0; nt < 4; ++nt)
            *(f32x4*)(sC + (wr * 64 + mt2 * 16 + (lane & 15)) * CLD + wc * 64 + nt * 16 + 4 * (lane >> 4)) = acc[4 * q + mt2][nt];
      }
      __syncthreads();
      run_epilogue(p, l, epi, b, m * 256 + q * 64, n * 256, tid, sC, ncols);
    }
  }
}

__device__ __forceinline__ uint2 pack4(float4 v) {
  uint2 pk;
  pk.x = pack2(v.x, v.y);
  pk.y = pack2(v.z, v.w);
  return pk;
}
__device__ __forceinline__ float4 unpack4(uint2 u) {
  float4 v;
  v.x = __uint_as_float(u.x << 16); v.y = __uint_as_float(u.x & 0xffff0000u);
  v.z = __uint_as_float(u.y << 16); v.w = __uint_as_float(u.y & 0xffff0000u);
  return v;
}
template <class F>
__device__ __forceinline__ void epi_each(int row0, int col0, int tid, const float* sC, int ncols, const F& f) {
#pragma unroll 2
  for (int j = 0; j < 16; ++j) {
    const int e = tid + NTHR * j;
    const int r = e >> 6, c = (e & 63) * 4;
    if (c < ncols) {
      const float4 v = *(const float4*)(sC + r * CLD + c);
      f(row0 + r + (r & 64), col0 + c, v);
    }
  }
}

struct EpiInProj {
  u16 *qb, *qi, *ki, *sga, *sgs, *ugm, *cn; float *wi; const float* kvg;
  __device__ __forceinline__ void run(int b, int row0, int col0, int tid, const float* sC, int ncols) const {
    const EpiInProj& s = *this;
    if (col0 == 512) {
      const int lane = tid & 63;
      const float4 gv = *(const float4*)(s.kvg + (lane & 31) * 4);
#pragma unroll 2
      for (int j = 0; j < 16; ++j) {
        const int e = tid + NTHR * j;
        const int r = e >> 6, c = (e & 63) * 4;
        const float4 v = *(const float4*)(sC + r * CLD + c);
        const long row = row0 + r + (r & 64);
        float ss = v.x * v.x + v.y * v.y + v.z * v.z + v.w * v.w;
        ss += __shfl_xor(ss, 16); ss += __shfl_xor(ss, 8); ss += __shfl_xor(ss, 4); ss += __shfl_xor(ss, 2); ss += __shfl_xor(ss, 1);
        if (c < 128) {
          const float rs = rsqrtf(ss * (1.f / 128.f) + 1e-6f);
          float4 w; w.x = v.x * rs * gv.x; w.y = v.y * rs * gv.y; w.z = v.z * rs * gv.z; w.w = v.w * rs * gv.w;
          *(uint2*)(s.cn + row * 128 + c) = pack4(w);
        } else {
          *(uint2*)(s.qi + row * 256 + (c - 128)) = pack4(v);
        }
      }
      return;
    }
    epi_each(row0, col0, tid, sC, ncols, [&](int row, int col, float4 v) {
      if (col < 512) *(uint2*)(s.qb + (long)row * 512 + col) = pack4(v);
      else if (col < 896) *(uint2*)(s.qi + (long)row * 256 + (col - 640)) = pack4(v);
      else if (col < 928) *(uint2*)(s.ki + (long)row * 32 + (col - 896)) = pack4(v);
      else if (col < 936) { float4 w = v; w.x *= 0.0625f; w.y *= 0.0625f; w.z *= 0.0625f; w.w *= 0.0625f; *(float4*)(s.wi + (long)row * 8 + (col - 928)) = w; }
      else if (col < 1024) {}
      else if (col < 1536) { float4 w; w.x = silu_f(v.x); w.y = silu_f(v.y); w.z = silu_f(v.z); w.w = silu_f(v.w); *(uint2*)(s.sga + (long)row * 512 + (col - 1024)) = pack4(w); }
      else if (col < 2048) { int cc = col - 1536; *(uint2*)(s.ugm + ((long)(cc >> 4) * NTOK + row) * 16 + (cc & 15)) = pack4(v); }
      else { float4 w; w.x = silu_f(v.x); w.y = silu_f(v.y); w.z = silu_f(v.z); w.w = silu_f(v.w); *(uint2*)(s.sgs + (long)row * 512 + (col - 2048)) = pack4(w); }
    });
  }
};
struct EpiQlat {
  u16* ql;
  __device__ __forceinline__ void run(int b, int row0, int col0, int tid, const float* sC, int ncols) const {
    u16* o = ql;
    epi_each(row0, col0, tid, sC, ncols, [&](int row, int col, float4 v) { *(uint2*)(o + (long)row * 1024 + b * 128 + col) = pack4(v); });
  }
};
struct EpiS {
  float* S;
  __device__ __forceinline__ void run(int b, int row0, int col0, int tid, const float* sC, int ncols) const {
    float* o = S;
    epi_each(row0, col0, tid, sC, ncols, [&](int row, int col, float4 v) { *(float4*)(o + ((long)b * NCHUNK + row) * 128 + col) = v; });
  }
};
struct EpiUv {
  const u16* sga; u16* mixed;
  __device__ __forceinline__ void run(int b, int row0, int col0, int tid, const float* sC, int ncols) const {
    const u16* g = sga; u16* o = mixed;
    epi_each(row0, col0, tid, sC, ncols, [&](int row, int col, float4 v) {
      int c2 = b * 128 + col;
      float4 gv = unpack4(*(const uint2*)(g + (long)row * 512 + c2));
      float4 w; w.x = v.x * gv.x; w.y = v.y * gv.y; w.z = v.z * gv.z; w.w = v.w * gv.w;
      *(uint2*)(o + (long)row * 1024 + c2) = pack4(w);
    });
  }
};
struct EpiY {
  const u16* ugm; const float* dsk; u16* yact;
  __device__ __forceinline__ void run(int b, int row0, int col0, int tid, const float* sC, int ncols) const {
    const u16* u = ugm; const float* dd = dsk; u16* o = yact;
    epi_each(row0, col0, tid, sC, ncols, [&](int row, int col, float4 v) {
      int t = col >> 4, c = col & 15;
      long token = (long)row * TCH + t;
      float4 uv = unpack4(*(const uint2*)(u + ((long)b * NTOK + token) * 16 + c));
      float4 dv = *(const float4*)(dd + b * 16 + c);
      float4 w;
      w.x = gelu_tanh(v.x + dv.x * uv.x); w.y = gelu_tanh(v.y + dv.y * uv.y);
      w.z = gelu_tanh(v.z + dv.z * uv.z); w.w = gelu_tanh(v.w + dv.w * uv.w);
      *(uint2*)(o + token * 512 + b * 16 + c) = pack4(w);
    });
  }
};
struct EpiGlu {
  const u16* sgs; const float* bglu; u16* mixed;
  __device__ __forceinline__ void run(int b, int row0, int col0, int tid, const float* sC, int ncols) const {
#pragma unroll 2
    for (int jj = 0; jj < 8; ++jj) {
      const int e = tid + NTHR * jj;
      const int r = e >> 5, q = e & 31, gi = q >> 3, qq = q & 7;
      const float4 va = *(const float4*)(sC + r * CLD + gi * 64 + qq * 4);
      const float4 ga = *(const float4*)(sC + r * CLD + gi * 64 + 32 + qq * 4);
      const int j = (col0 >> 1) + gi * 32 + qq * 4;
      const long row = row0 + r + (r & 64);
      const float4 bv = *(const float4*)(bglu + j), bg = *(const float4*)(bglu + 512 + j);
      const float4 sg = unpack4(*(const uint2*)(sgs + row * 512 + j));
      float4 w;
      w.x = (va.x + bv.x) * sigmoid_fast(ga.x + bg.x) * sg.x;
      w.y = (va.y + bv.y) * sigmoid_fast(ga.y + bg.y) * sg.y;
      w.z = (va.z + bv.z) * sigmoid_fast(ga.z + bg.z) * sg.z;
      w.w = (va.w + bv.w) * sigmoid_fast(ga.w + bg.w) * sg.w;
      *(uint2*)(mixed + row * 1024 + 512 + j) = pack4(w);
    }
  }
};
struct EpiOut {
  const float* xin; float* z; const float* stats; const float* g; const float* bb; int first;
  __device__ __forceinline__ void run(int b, int row0, int col0, int tid, const float* sC, int ncols) const {
    const EpiOut& s = *this;
    epi_each(row0, col0, tid, sC, ncols, [&](int row, int col, float4 v) {
      long idx = (long)row * 1024 + col;
      float4 xp;
      if (s.first) xp = *(const float4*)(s.xin + idx);
      else {
        float mu = s.stats[2 * row], rs = s.stats[2 * row + 1];
        float4 zo = *(const float4*)(s.z + idx), gv = *(const float4*)(s.g + col), bv = *(const float4*)(s.bb + col);
        xp.x = (zo.x - mu) * rs * gv.x + bv.x; xp.y = (zo.y - mu) * rs * gv.y + bv.y;
        xp.z = (zo.z - mu) * rs * gv.z + bv.z; xp.w = (zo.w - mu) * rs * gv.w + bv.w;
      }
      float4 o; o.x = ALPHA * xp.x + v.x; o.y = ALPHA * xp.y + v.y; o.z = ALPHA * xp.z + v.z; o.w = ALPHA * xp.w + v.w;
      *(float4*)(s.z + idx) = o;
    });
  }
};

template <class CM>
__device__ __forceinline__ void transpose_tile(const Ctx& cx, const float* src, int sld, u16* dst, int dld, int k0, int n0, const CM& colmap, char* smem) {
  float* tile = (float*)smem;
  const int tid = cx.tid;
  __syncthreads();
  for (int e = tid; e < 4096; e += NTHR) {
    int kk = e >> 6, nn = e & 63;
    int sc = colmap(n0 + nn);
    tile[kk * 65 + nn] = sc >= 0 ? src[(long)(k0 + kk) * sld + sc] : 0.f;
  }
  __syncthreads();
  for (int e = tid; e < 4096; e += NTHR) {
    int nn = e >> 6, kk = e & 63;
    dst[(long)(n0 + nn) * dld + k0 + kk] = f2bf(tile[kk * 65 + nn]);
  }
}

__device__ __forceinline__ void ssm_ops(const Ctx& cx, const Params& p, int l, int g, char* smem) {
  float* ap = (float*)smem;
  float* bbm = ap + 17 * 64 * 2;
  float* ccm = bbm + 64 * 16 * 2;
  float* kj = ccm + 16 * 64 * 2;
  const int tid = cx.tid;
  const int lg = l * NGRP + g;
  __syncthreads();
  if (tid < 64) {
    const int pp = tid;
    float dt = expf(p.log_dt[lg]);
    float lr = p.a_re[lg * 64 + pp], li = p.a_im[lg * 64 + pp];
    for (int j = 0; j <= 16; ++j) {
      float mag = expf(lr * dt * (float)j);
      float sn, cs; sincosf(li * dt * (float)j, &sn, &cs);
      ap[(j * 64 + pp) * 2] = mag * cs; ap[(j * 64 + pp) * 2 + 1] = mag * sn;
    }
    float ar = ap[(1 * 64 + pp) * 2], ai = ap[(1 * 64 + pp) * 2 + 1];
    float den = lr * lr + li * li;
    float cr = ((ar - 1.f) * lr + ai * li) / den;
    float ci = (ai * lr - (ar - 1.f) * li) / den;
    for (int c = 0; c < 16; ++c) {
      float br = p.b_re[((long)lg * 64 + pp) * 16 + c], bi = p.b_im[((long)lg * 64 + pp) * 16 + c];
      bbm[(pp * 16 + c) * 2] = cr * br - ci * bi;
      bbm[(pp * 16 + c) * 2 + 1] = cr * bi + ci * br;
    }
    float* at = (float*)(p.ws + OFF_AT) + ((long)lg * 64 + pp) * 2;
    at[0] = ap[(16 * 64 + pp) * 2]; at[1] = ap[(16 * 64 + pp) * 2 + 1];
  }
  for (int e = tid; e < 1024; e += NTHR) {
    ccm[e * 2] = p.c_re[(long)lg * 1024 + e];
    ccm[e * 2 + 1] = p.c_im[(long)lg * 1024 + e];
  }
  __syncthreads();
  for (int e = tid; e < 4096; e += NTHR) {
    int j = e >> 8, cp = (e >> 4) & 15, c = e & 15;
    float s = 0.f;
    for (int pp = 0; pp < 64; ++pp) {
      float c_r = ccm[(cp * 64 + pp) * 2], c_i = ccm[(cp * 64 + pp) * 2 + 1];
      float a_r = ap[(j * 64 + pp) * 2], a_i = ap[(j * 64 + pp) * 2 + 1];
      float er = c_r * a_r - c_i * a_i, ei = c_r * a_i + c_i * a_r;
      s += er * bbm[(pp * 16 + c) * 2] - ei * bbm[(pp * 16 + c) * 2 + 1];
    }
    kj[e] = s;
  }
  __syncthreads();
  u16* op2 = (u16*)(p.ws + OFF_OP2) + (long)lg * 256 * 384;
  for (int e = tid; e < 256 * 384; e += NTHR) {
    int n = e / 384, k = e - n * 384;
    int t = n >> 4, cp = n & 15;
    float v;
    if (k < 256) {
      int s = k >> 4, c = k & 15;
      v = (s <= t) ? kj[((t - s) * 16 + cp) * 16 + c] : 0.f;
    } else {
      int j = k - 256, pp = j & 63;
      float c_r = ccm[(cp * 64 + pp) * 2], c_i = ccm[(cp * 64 + pp) * 2 + 1];
      float a_r = ap[((t + 1) * 64 + pp) * 2], a_i = ap[((t + 1) * 64 + pp) * 2 + 1];
      v = (j < 64) ? (c_r * a_r - c_i * a_i) : -(c_r * a_i + c_i * a_r);
    }
    op2[e] = f2bf(v);
  }
  u16* op1 = (u16*)(p.ws + OFF_OP1) + (long)lg * 128 * 256;
  for (int e = tid; e < 128 * 256; e += NTHR) {
    int j = e >> 8, k = e & 255;
    int pp = j & 63, s = k >> 4, c = k & 15;
    float a_r = ap[((15 - s) * 64 + pp) * 2], a_i = ap[((15 - s) * 64 + pp) * 2 + 1];
    float b_r = bbm[(pp * 16 + c) * 2], b_i = bbm[(pp * 16 + c) * 2 + 1];
    float v = (j < 64) ? (a_r * b_r - a_i * b_i) : (a_r * b_i + a_i * b_r);
    op1[e] = f2bf(v);
  }
}

__device__ __forceinline__ void prologue_phase(const Ctx& cx, const Params& p, char* smem) {
  const int G = cx.G, bid = cx.bid, tid = cx.tid;
  for (int it = bid; it < DEPTH * NGRP; it += G) ssm_ops(cx, p, it / NGRP, it % NGRP, smem);
  for (int it = bid; it < DEPTH * 16 * 40; it += G) {
    int l = it / 640, r = it % 640, kt = r / 40, ntile = r % 40;
    transpose_tile(cx, p.w_in + (long)l * DM * DIN, DIN, (u16*)(p.ws + OFF_WINT) + (long)l * NPAD * DM, DM, kt * 64, ntile * 64,
                   [](int n) { return n < 936 ? n : (n < 1024 ? -1 : n - 88); }, smem);
  }
  for (int it = bid; it < DEPTH * 256; it += G) {
    int l = it >> 8, r = it & 255, kt = r >> 4, ntile = r & 15;
    transpose_tile(cx, p.w_out + (long)l * DM * DM, DM, (u16*)(p.ws + OFF_WOUTT) + (long)l * DM * DM, DM, kt * 64, ntile * 64,
                   [](int n) { return n; }, smem);
  }
  for (int it = bid; it < DEPTH * 128; it += G) {
    int l = it >> 7, r = it & 127, kt = r >> 4, ntile = r & 15;
    transpose_tile(cx, p.w_glu + (long)l * 512 * 1024, 1024, (u16*)(p.ws + OFF_WGLUT) + (long)l * 1024 * 512, 512, kt * 64, ntile * 64,
                   [](int n) { return ((n >> 5) & 1) * 512 + (n >> 6) * 32 + (n & 31); }, smem);
  }
  const long gtid = (long)bid * NTHR + tid, gsz = (long)G * NTHR;
  {
    u16* o = (u16*)(p.ws + OFF_WUK);
    for (long e = gtid; e < (long)DEPTH * 8 * 128 * 64; e += gsz) o[e] = f2bf(0.125f * 1.4426950408889634f * p.w_uk[e]);
  }
  {
    u16* o = (u16*)(p.ws + OFF_WUVP);
    for (long e = gtid; e < (long)DEPTH * 4 * 128 * 256; e += gsz) {
      int k = e & 255, n = (e >> 8) & 127, j = (e >> 15) & 3, l = (int)(e >> 17);
      int hh = n >> 6, dd = n & 63, hh2 = k >> 7, c = k & 127;
      float v = (hh == hh2) ? p.w_uv[(((long)l * 8 + 2 * j + hh) * 128 + c) * 64 + dd] : 0.f;
      o[e] = f2bf(v);
    }
  }
  {
    u16* o = (u16*)(p.ws + OFF_XB);
    const float4* xi = (const float4*)p.x;
    for (long e = gtid; e < (long)NTOK * DM / 4; e += gsz) {
      float4 v = xi[e];
      uint2 pk;
      pk.x = pack2(v.x, v.y);
      pk.y = pack2(v.z, v.w);
      *(uint2*)(o + e * 4) = pk;
    }
  }
}

__device__ __forceinline__ void rmsnorm_pass(const Ctx& cx, const Params& p, int l) {
  const float* ckv = (const float*)(p.ws + OFF_CKV);
  u16* cn = (u16*)(p.ws + OFF_CN);
  const float* g = p.kvg + l * 128;
  const int lane = cx.tid & 63, half = lane >> 5, l32 = lane & 31;
  const long gw = (long)cx.bid * NWV + (cx.tid >> 6), nw = (long)cx.G * NWV;
  const float4 gv = *(const float4*)(g + l32 * 4);
  for (long it = gw; it < NTOK / 2; it += nw) {
    long tok = it * 2 + half;
    float4 v = *(const float4*)(ckv + tok * 128 + l32 * 4);
    float ss = v.x * v.x + v.y * v.y + v.z * v.z + v.w * v.w;
    ss += __shfl_xor(ss, 16); ss += __shfl_xor(ss, 8); ss += __shfl_xor(ss, 4); ss += __shfl_xor(ss, 2); ss += __shfl_xor(ss, 1);
    float rs = rsqrtf(ss * (1.f / 128.f) + 1e-6f);
    uint2 pk;
    pk.x = pack2(v.x * rs * gv.x, v.y * rs * gv.y);
    pk.y = pack2(v.z * rs * gv.z, v.w * rs * gv.w);
    *(uint2*)(cn + tok * 128 + l32 * 4) = pk;
  }
}

__device__ __forceinline__ void layernorm_pass(const Ctx& cx, const Params& p, int l) {
  float* z = p.out;
  float* stats = (float*)(p.ws + OFF_STATS);
  u16* xb = (u16*)(p.ws + OFF_XB);
  const float* g = p.ln_g + l * DM; const float* bb = p.ln_b + l * DM;
  const int lane = cx.tid & 63;
  const long gw = (long)cx.bid * NWV + (cx.tid >> 6), nw = (long)cx.G * NWV;
  float4 gv[4], bv[4];
#pragma unroll
  for (int j = 0; j < 4; ++j) { gv[j] = *(const float4*)(g + j * 256 + lane * 4); bv[j] = *(const float4*)(bb + j * 256 + lane * 4); }
  for (long row = gw; row < NTOK; row += nw) {
    float4 v[4];
    float s = 0.f;
#pragma unroll
    for (int j = 0; j < 4; ++j) { v[j] = *(const float4*)(z + row * DM + j * 256 + lane * 4); s += v[j].x + v[j].y + v[j].z + v[j].w; }
#pragma unroll
    for (int o = 32; o >= 1; o >>= 1) s += __shfl_xor(s, o);
    float mu = s * (1.f / 1024.f);
    float q = 0.f;
#pragma unroll
    for (int j = 0; j < 4; ++j) {
      float a = v[j].x - mu, b = v[j].y - mu, c = v[j].z - mu, d = v[j].w - mu;
      q += a * a + b * b + c * c + d * d;
    }
#pragma unroll
    for (int o = 32; o >= 1; o >>= 1) q += __shfl_xor(q, o);
    float rs = rsqrtf(q * (1.f / 1024.f) + 1e-5f);
    if (l == DEPTH - 1) {
#pragma unroll
      for (int j = 0; j < 4; ++j) {
        float4 o;
        o.x = (v[j].x - mu) * rs * gv[j].x + bv[j].x; o.y = (v[j].y - mu) * rs * gv[j].y + bv[j].y;
        o.z = (v[j].z - mu) * rs * gv[j].z + bv[j].z; o.w = (v[j].w - mu) * rs * gv[j].w + bv[j].w;
        *(float4*)(z + row * DM + j * 256 + lane * 4) = o;
      }
    } else {
      if (lane == 0) { stats[2 * row] = mu; stats[2 * row + 1] = rs; }
#pragma unroll
      for (int j = 0; j < 4; ++j) {
        float a = (v[j].x - mu) * rs * gv[j].x + bv[j].x, b = (v[j].y - mu) * rs * gv[j].y + bv[j].y;
        float c = (v[j].z - mu) * rs * gv[j].z + bv[j].z, d = (v[j].w - mu) * rs * gv[j].w + bv[j].w;
        uint2 pk;
        pk.x = pack2(a, b);
        pk.y = pack2(c, d);
        *(uint2*)(xb + row * DM + j * 256 + lane * 4) = pk;
      }
    }
  }
}

__device__ __forceinline__ void scan_pass(const Ctx& cx, const Params& p, int l) {
  const float* S = (const float*)(p.ws + OFF_S);
  u16* Xin = (u16*)(p.ws + OFF_CKV);
  const int lane = cx.tid & 63;
  const int gw = cx.bid * NWV + (cx.tid >> 6), nw = cx.G * NWV;
  for (int it = gw; it < NBATCH * NGRP; it += nw) {
    int b = it >> 5, g = it & 31;
    const float* at = (const float*)(p.ws + OFF_AT) + ((long)(l * NGRP + g) * 64 + lane) * 2;
    const float ar = at[0], ai = at[1];
    float xr = 0.f, xi = 0.f;
    long row0 = (long)g * NCHUNK + b * 256;
    for (int k0 = 0; k0 < 256; k0 += 32) {
      float sr[32], si[32];
#pragma unroll
      for (int j = 0; j < 32; ++j) { sr[j] = S[(row0 + k0 + j) * 128 + lane]; si[j] = S[(row0 + k0 + j) * 128 + 64 + lane]; }
#pragma unroll
      for (int j = 0; j < 32; ++j) {
        Xin[(row0 + k0 + j) * 128 + lane] = f2bf(xr);
        Xin[(row0 + k0 + j) * 128 + 64 + lane] = f2bf(xi);
        float nr = ar * xr - ai * xi + sr[j];
        float ni = ar * xi + ai * xr + si[j];
        xr = nr; xi = ni;
      }
    }
  }
}

__device__ __forceinline__ unsigned sortable(float f) {
  unsigned u = __float_as_uint(f);
  return u ^ ((unsigned)((int)u >> 31) | 0x80000000u);
}
__device__ __forceinline__ int mbcnt64(u64 m) {
  return __builtin_amdgcn_mbcnt_hi((unsigned)(m >> 32), __builtin_amdgcn_mbcnt_lo((unsigned)m, 0));
}

__device__ __forceinline__ void attn_phase(const Ctx& cx, const Params& p, char* smem) {
  const u16* qi = (const u16*)(p.ws + OFF_QI);
  const u16* ki = (const u16*)(p.ws + OFF_KI);
  const float* wi = (const float*)(p.ws + OFF_WI);
  const u16* cn = (const u16*)(p.ws + OFF_CN);
  u16* ql = (u16*)(p.ws + OFF_QL);
  const int tid = cx.tid, lane = tid & 63, wid = __builtin_amdgcn_readfirstlane(tid >> 6);
  const int hh = lane >> 5;
  const int G = cx.G;
  for (int item = cx.bid; item < (SEQL / 8) * NBATCH; item += G) {
    const int tq = (SEQL / 8 - 1) - (item >> 4), b = item & 15;
    const int t0 = tq * 8;
    const long tokbase = (long)b * SEQL;
    {
      const int r = lane & 31;
      const int qq = 2 * ((r >> 2) & 1) + (r >> 4), head = (r & 3) + 4 * ((r >> 3) & 1);
      const u16* qip = qi + (tokbase + t0 + qq) * 256 + head * 32 + 8 * hh;
      const bf16x8 qa0 = *(const bf16x8*)qip, qa1 = *(const bf16x8*)(qip + 16);
      const bf16x8 qb0 = *(const bf16x8*)(qip + 4 * 256), qb1 = *(const bf16x8*)(qip + 4 * 256 + 16);
      float w0[8], w1[8], w2[8], w3[8];
      {
        const float4* wp = (const float4*)(wi + (tokbase + t0 + 2 * hh) * 8);
        float4 a = wp[0], bq = wp[1], c = wp[2], d = wp[3];
        w0[0] = a.x; w0[1] = a.y; w0[2] = a.z; w0[3] = a.w; w0[4] = bq.x; w0[5] = bq.y; w0[6] = bq.z; w0[7] = bq.w;
        w1[0] = c.x; w1[1] = c.y; w1[2] = c.z; w1[3] = c.w; w1[4] = d.x; w1[5] = d.y; w1[6] = d.z; w1[7] = d.w;
        const float4* wq = (const float4*)(wi + (tokbase + t0 + 4 + 2 * hh) * 8);
        a = wq[0]; bq = wq[1]; c = wq[2]; d = wq[3];
        w2[0] = a.x; w2[1] = a.y; w2[2] = a.z; w2[3] = a.w; w2[4] = bq.x; w2[5] = bq.y; w2[6] = bq.z; w2[7] = bq.w;
        w3[0] = c.x; w3[1] = c.y; w3[2] = c.z; w3[3] = c.w; w3[4] = d.x; w3[5] = d.y; w3[6] = d.z; w3[7] = d.w;
      }
      const int ntiles = ((t0 + 7) >> 5) + 1;
      const int q0 = t0 + 2 * hh;
      unsigned* sc0 = (unsigned*)(smem + (2 * hh) * REG_STRIDE);
      unsigned* sc1 = (unsigned*)(smem + (2 * hh + 1) * REG_STRIDE);
      unsigned* sc2 = (unsigned*)(smem + (4 + 2 * hh) * REG_STRIDE);
      unsigned* sc3 = (unsigned*)(smem + (4 + 2 * hh + 1) * REG_STRIDE);
      __syncthreads();
      bf16x8 nk0, nk1;
      {
        const u16* kp = ki + (tokbase + min(wid, ntiles - 1) * 32 + r) * 32 + 8 * hh;
        nk0 = *(const bf16x8*)kp; nk1 = *(const bf16x8*)(kp + 16);
      }
      for (int tile = wid; tile < ntiles; tile += NWV) {
        const int key = tile * 32 + r;
        const bf16x8 kb0 = nk0, kb1 = nk1;
        {
          const u16* kp = ki + (tokbase + min(tile + NWV, ntiles - 1) * 32 + r) * 32 + 8 * hh;
          nk0 = *(const bf16x8*)kp; nk1 = *(const bf16x8*)(kp + 16);
        }
        f32x16 acc, acd;
#pragma unroll
        for (int e = 0; e < 16; ++e) { acc[e] = 0.f; acd[e] = 0.f; }
        acc = __builtin_amdgcn_mfma_f32_32x32x16_bf16(qa0, kb0, acc, 0, 0, 0);
        acd = __builtin_amdgcn_mfma_f32_32x32x16_bf16(qb0, kb0, acd, 0, 0, 0);
        acc = __builtin_amdgcn_mfma_f32_32x32x16_bf16(qa1, kb1, acc, 0, 0, 0);
        acd = __builtin_amdgcn_mfma_f32_32x32x16_bf16(qb1, kb1, acd, 0, 0, 0);
        float s0 = 0.f, s1 = 0.f, s2 = 0.f, s3 = 0.f;
#pragma unroll
        for (int e = 0; e < 8; ++e) {
          s0 += w0[e] * fmaxf(acc[e], 0.f); s1 += w1[e] * fmaxf(acc[8 + e], 0.f);
          s2 += w2[e] * fmaxf(acd[e], 0.f); s3 += w3[e] * fmaxf(acd[8 + e], 0.f);
        }
        sc0[key] = (key <= q0) ? sortable(s0) : 0u;
        sc1[key] = (key <= q0 + 1) ? sortable(s1) : 0u;
        sc2[key] = (key <= q0 + 4) ? sortable(s2) : 0u;
        sc3[key] = (key <= q0 + 5) ? sortable(s3) : 0u;
      }
      __syncthreads();
    }
    const int t = t0 + wid;
    char* reg = smem + wid * REG_STRIDE;
    const unsigned* sc = (const unsigned*)reg;
    u16* sel = (u16*)(reg + 18432);
    const int nvalid = t + 1;
    int count;
    if (nvalid <= 256) {
      count = nvalid;
      for (int i = lane; i < 256; i += 64) sel[i] = (u16)(i < nvalid ? i : 0);
    } else {
      count = 256;
      unsigned v[64];
#pragma unroll
      for (int i = 0; i < 64; ++i) { int key = i * 64 + lane; v[i] = (key < nvalid) ? sc[key] : 0u; }
      const int ni = (nvalid + 63) >> 6;
#define CNT_GE(THR, CNT) do { \
        int c_ = 0; \
        _Pragma("unroll") for (int gq = 0; gq < 4; ++gq) { \
          if (gq * 16 < ni) { \
            _Pragma("unroll") for (int j = 0; j < 16; ++j) c_ += __builtin_popcountll(__ballot(v[gq * 16 + j] >= (THR))); \
          } \
        } \
        CNT = c_; } while (0)
      unsigned vmax = 0u;
#pragma unroll
      for (int i = 0; i < 64; ++i) vmax = max(vmax, v[i]);
#pragma unroll
      for (int o = 32; o >= 1; o >>= 1) vmax = max(vmax, (unsigned)__shfl_xor((int)vmax, o));
      vmax = (unsigned)__builtin_amdgcn_readfirstlane((int)vmax);
      unsigned lo = 0u, hi = vmax + 1u;
      int clo = 4096, chi = 0;
      bool positive = false;
      {
        int c0; CNT_GE(0x80000000u, c0);
        if (c0 >= 256) { lo = 0x80000000u; clo = c0; positive = true; }
        else { hi = 0x80000000u; chi = c0; }
      }
      while (clo != 256 && clo - chi > 128 && hi - lo > 1u) {
        unsigned mid = lo + ((hi - lo) >> 1);
        if (positive) {
          const float fm = 0.5f * (__uint_as_float(lo & 0x7fffffffu) + __uint_as_float(hi & 0x7fffffffu));
          const unsigned m2 = __float_as_uint(fm) | 0x80000000u;
          if (m2 > lo && m2 < hi) mid = m2;
        }
        int cnt; CNT_GE(mid, cnt);
        if (cnt >= 256) { lo = mid; clo = cnt; } else { hi = mid; chi = cnt; }
      }
      if (clo <= 384) {
        unsigned* dval = (unsigned*)(reg + 8192);
        u16* dkey = (u16*)(reg + 8192 + 1536);
        {
          int base = 0;
#pragma unroll
          for (int gq = 0; gq < 4; ++gq) {
            if (gq * 16 < ni) {
#pragma unroll
              for (int j = 0; j < 16; ++j) {
                const int i = gq * 16 + j;
                const bool in = v[i] >= lo;
                const u64 m = __ballot(in);
                if (in) { const int pos = base + mbcnt64(m); dval[pos] = v[i]; dkey[pos] = (u16)(i * 64 + lane); }
                base += __builtin_popcountll(m);
              }
            }
          }
        }
        unsigned dv[6]; int dk[6];
#pragma unroll
        for (int j = 0; j < 6; ++j) {
          const int idx = j * 64 + lane;
          dv[j] = (idx < clo) ? dval[idx] : 0u;
          dk[j] = (idx < clo) ? (int)dkey[idx] : 0;
        }
        while (clo != 256 && hi - lo > 1u) {
          const unsigned mid = lo + ((hi - lo) >> 1);
          int cnt = 0;
#pragma unroll
          for (int j = 0; j < 6; ++j) cnt += __builtin_popcountll(__ballot(dv[j] >= mid));
          if (cnt >= 256) { lo = mid; clo = cnt; } else { hi = mid; chi = cnt; }
        }
        int base = 0, eqleft = (clo == 256) ? 512 : 256 - chi;
#pragma unroll
        for (int j = 0; j < 6; ++j) {
          const bool gt = dv[j] > lo, eq = dv[j] == lo;
          const u64 meq = __ballot(eq);
          const bool take = gt || (eq && mbcnt64(meq) < eqleft);
          const u64 mt = __ballot(take);
          if (take) sel[base + mbcnt64(mt)] = (u16)dk[j];
          base += __builtin_popcountll(mt);
          eqleft -= min((int)__builtin_popcountll(meq), eqleft);
        }
      } else {
        int base = 0, eqleft = 256 - chi;
#pragma unroll
        for (int gq = 0; gq < 4; ++gq) {
          if (gq * 16 < ni) {
#pragma unroll
            for (int j = 0; j < 16; ++j) {
              const int i = gq * 16 + j;
              const bool gt = v[i] > lo, eq = v[i] == lo;
              const u64 meq = __ballot(eq);
              const bool take = gt || (eq && mbcnt64(meq) < eqleft);
              const u64 mt = __ballot(take);
              if (take) sel[base + mbcnt64(mt)] = (u16)(i * 64 + lane);
              base += __builtin_popcountll(mt);
              eqleft -= min((int)__builtin_popcountll(meq), eqleft);
              if ((j & 3) == 3) __builtin_amdgcn_sched_barrier(0);
            }
          }
        }
      }
    }
    {
      const long token = tokbase + t;
      const int hd = lane & 15, g4 = lane >> 4;
      bf16x8 qf[4];
#pragma unroll
      for (int ks = 0; ks < 4; ++ks) {
        if (hd < 8) qf[ks] = *(const bf16x8*)(ql + token * 1024 + hd * 128 + 32 * ks + 8 * g4);
        else { for (int e = 0; e < 8; ++e) qf[ks][e] = 0; }
      }
      const int nch = (count + 31) >> 5;
      f32x4 o[8];
#pragma unroll
      for (int c = 0; c < 8; ++c) o[c] = (f32x4){0.f, 0.f, 0.f, 0.f};
      float mrun = -1e30f, lsum = 0.f;
      const int qd = (lane & 15) >> 2, pq = lane & 3;
      bf16x8 kr[8];
#define LOADK32(JJ) do { \
        _Pragma("unroll") for (int j = 0; j < 8; ++j) { \
          const int key_ = sel[32 * (JJ) + 4 * j + g4]; \
          kr[j] = *(const bf16x8*)(cn + (tokbase + key_) * 128 + 8 * hd); \
        } } while (0)
      LOADK32(0);
      for (int jj = 0; jj < nch; ++jj) {
#pragma unroll
        for (int j = 0; j < 8; ++j) *(bf16x8*)(reg + (4 * j + g4) * KROW + hd * 16) = kr[j];
        __builtin_amdgcn_sched_barrier(0);
        if (jj + 1 < nch) LOADK32(jj + 1);
        __builtin_amdgcn_sched_barrier(0);
        f32x4 sacc[2];
#pragma unroll
        for (int tt = 0; tt < 2; ++tt) {
          sacc[tt] = (f32x4){0.f, 0.f, 0.f, 0.f};
#pragma unroll
          for (int ks = 0; ks < 4; ++ks) {
            const bf16x8 kfr = *(const bf16x8*)(reg + (16 * tt + hd) * KROW + (32 * ks + 8 * g4) * 2);
            sacc[tt] = __builtin_amdgcn_mfma_f32_16x16x32_bf16(kfr, qf[ks], sacc[tt], 0, 0, 0);
          }
        }
        if (32 * jj + 32 > count) {
#pragma unroll
          for (int tt = 0; tt < 2; ++tt)
#pragma unroll
            for (int i = 0; i < 4; ++i) {
              const int slot = 32 * jj + 16 * tt + 4 * g4 + i;
              if (slot >= count) sacc[tt][i] = -1e30f;
            }
        }
        float mloc = fmaxf(fmaxf(fmaxf(sacc[0][0], sacc[0][1]), fmaxf(sacc[0][2], sacc[0][3])),
                           fmaxf(fmaxf(sacc[1][0], sacc[1][1]), fmaxf(sacc[1][2], sacc[1][3])));
        mloc = fmaxf(mloc, __shfl_xor(mloc, 16));
        mloc = fmaxf(mloc, __shfl_xor(mloc, 32));
        const float mnew = fmaxf(mrun, mloc);
        const float alpha = __builtin_amdgcn_exp2f(mrun - mnew);
        mrun = mnew;
        float pv[8];
#pragma unroll
        for (int tt = 0; tt < 2; ++tt)
#pragma unroll
          for (int i = 0; i < 4; ++i) pv[tt * 4 + i] = __builtin_amdgcn_exp2f(sacc[tt][i] - mnew);
        const float ps = ((pv[0] + pv[1]) + (pv[2] + pv[3])) + ((pv[4] + pv[5]) + (pv[6] + pv[7]));
        bf16x8 pb;
        {
          unsigned* pw = (unsigned*)&pb;
          pw[0] = pack2(pv[0], pv[1]); pw[1] = pack2(pv[2], pv[3]); pw[2] = pack2(pv[4], pv[5]); pw[3] = pack2(pv[6], pv[7]);
        }
        lsum = lsum * alpha + ps;
#pragma unroll
        for (int c = 0; c < 8; ++c) { o[c][0] *= alpha; o[c][1] *= alpha; o[c][2] *= alpha; o[c][3] *= alpha; }
#pragma unroll
        for (int c = 0; c < 8; ++c) {
          const unsigned a_lo = (unsigned)(size_t)(reg) ;
          (void)a_lo;
          s16x4 lo = __builtin_amdgcn_ds_read_tr16_b64_v4i16(
              (s16x4 __attribute__((address_space(3)))*)(reg + (4 * g4 + qd) * KROW + (16 * c + 4 * pq) * 2));
          s16x4 hi = __builtin_amdgcn_ds_read_tr16_b64_v4i16(
              (s16x4 __attribute__((address_space(3)))*)(reg + (16 + 4 * g4 + qd) * KROW + (16 * c + 4 * pq) * 2));
          bf16x8 vf;
          vf[0] = lo[0]; vf[1] = lo[1]; vf[2] = lo[2]; vf[3] = lo[3];
          vf[4] = hi[0]; vf[5] = hi[1]; vf[6] = hi[2]; vf[7] = hi[3];
          o[c] = __builtin_amdgcn_mfma_f32_16x16x32_bf16(vf, pb, o[c], 0, 0, 0);
        }
      }
      lsum += __shfl_xor(lsum, 16);
      lsum += __shfl_xor(lsum, 32);
      const float inv = 1.f / lsum;
      if (hd < 8) {
#pragma unroll
        for (int c = 0; c < 8; ++c) {
          uint2 pk;
          pk.x = pack2(o[c][0] * inv, o[c][1] * inv);
          pk.y = pack2(o[c][2] * inv, o[c][3] * inv);
          *(uint2*)(ql + token * 1024 + hd * 128 + 16 * c + 4 * g4) = pk;
        }
      }
    }
  }
}

__device__ __forceinline__ void run_epilogue(const Params& p, int l, int epi, int b, int row0, int col0, int tid, const float* sC, int ncols) {
  char* ws = p.ws;
  switch (epi) {
    case 0: { EpiInProj e{(u16*)(ws + OFF_QB), (u16*)(ws + OFF_QI), (u16*)(ws + OFF_KI), (u16*)(ws + OFF_SGA), (u16*)(ws + OFF_SGS),
                          (u16*)(ws + OFF_UGM), (u16*)(ws + OFF_CN), (float*)(ws + OFF_WI), p.kvg + l * 128};
              e.run(b, row0, col0, tid, sC, ncols); } break;
    case 1: { EpiQlat e{(u16*)(ws + OFF_QL)}; e.run(b, row0, col0, tid, sC, ncols); } break;
    case 2: { EpiS e{(float*)(ws + OFF_S)}; e.run(b, row0, col0, tid, sC, ncols); } break;
    case 3: { EpiUv e{(const u16*)(ws + OFF_SGA), (u16*)(ws + OFF_XB)}; e.run(b, row0, col0, tid, sC, ncols); } break;
    case 4: { EpiY e{(const u16*)(ws + OFF_UGM), p.d_skip + l * 512, (u16*)(ws + OFF_QB)}; e.run(b, row0, col0, tid, sC, ncols); } break;
    case 5: { EpiGlu e{(const u16*)(ws + OFF_SGS), p.b_glu + l * 1024, (u16*)(ws + OFF_XB)}; e.run(b, row0, col0, tid, sC, ncols); } break;
    default: { EpiOut e{p.x, p.out, (const float*)(ws + OFF_STATS), p.ln_g + (l > 0 ? l - 1 : 0) * DM, p.ln_b + (l > 0 ? l - 1 : 0) * DM, l == 0 ? 1 : 0};
               e.run(b, row0, col0, tid, sC, ncols); } break;
  }
}

__device__ __forceinline__ void make_desc(GemmDesc& d, const Params& p, int l, int op) {
  char* ws = p.ws;
  d.A2 = nullptr; d.a2_bs = 0; d.lda2 = 0; d.ksplit = 1 << 30;
  switch (op) {
    case 0:
      d.A = (const u16*)(ws + OFF_XB); d.lda = DM; d.a_bs = 0;
      d.Bt = (const u16*)(ws + OFF_WINT) + (long)l * NPAD * DM; d.ldb = DM; d.b_bs = 0;
      d.M = NTOK; d.N = NPAD; d.K = DM; d.nbatch = 1; break;
    case 1:
      d.A = (const u16*)(ws + OFF_QB); d.lda = 512; d.a_bs = 64;
      d.Bt = (const u16*)(ws + OFF_WUK) + (long)l * 8 * 128 * 64; d.ldb = 64; d.b_bs = 128 * 64;
      d.M = NTOK; d.N = 128; d.K = 64; d.nbatch = 8; break;
    case 2:
      d.A = (const u16*)(ws + OFF_UGM); d.lda = 256; d.a_bs = (long)NTOK * 16;
      d.Bt = (const u16*)(ws + OFF_OP1) + (long)l * NGRP * 128 * 256; d.ldb = 256; d.b_bs = 128 * 256;
      d.M = NCHUNK; d.N = 128; d.K = 256; d.nbatch = NGRP; break;
    case 3:
      d.A = (const u16*)(ws + OFF_QL); d.lda = 1024; d.a_bs = 256;
      d.Bt = (const u16*)(ws + OFF_WUVP) + (long)l * 4 * 128 * 256; d.ldb = 256; d.b_bs = 128 * 256;
      d.M = NTOK; d.N = 128; d.K = 256; d.nbatch = 4; break;
    case 4:
      d.A = (const u16*)(ws + OFF_UGM); d.lda = 256; d.a_bs = (long)NTOK * 16;
      d.A2 = (const u16*)(ws + OFF_CKV); d.lda2 = 128; d.a2_bs = (long)NCHUNK * 128; d.ksplit = 256;
      d.Bt = (const u16*)(ws + OFF_OP2) + (long)l * NGRP * 256 * 384; d.ldb = 384; d.b_bs = 256 * 384;
      d.M = NCHUNK; d.N = 256; d.K = 384; d.nbatch = NGRP; break;
    case 5:
      d.A = (const u16*)(ws + OFF_QB); d.lda = 512; d.a_bs = 0;
      d.Bt = (const u16*)(ws + OFF_WGLUT) + (long)l * 1024 * 512; d.ldb = 512; d.b_bs = 0;
      d.M = NTOK; d.N = 1024; d.K = 512; d.nbatch = 1; break;
    default:
      d.A = (const u16*)(ws + OFF_XB); d.lda = DM; d.a_bs = 0;
      d.Bt = (const u16*)(ws + OFF_WOUTT) + (long)l * DM * DM; d.ldb = DM; d.b_bs = 0;
      d.M = NTOK; d.N = DM; d.K = DM; d.nbatch = 1; break;
  }
}

__device__ __forceinline__ void run_phase(const Params& p, int ph, char* smem) {
  Ctx cx; cx.tid = threadIdx.x; cx.bid = blockIdx.x; cx.G = gridDim.x;
  OPAQUE_V(cx.tid); OPAQUE_S(cx.bid); OPAQUE_S(cx.G);
  if (ph == 0) { prologue_phase(cx, p, smem); return; }
  const int l = (ph - 1) / 7, s = (ph - 1) % 7;
  int op0 = -1, nops = 0;
  if (s == 0) { op0 = 0; nops = 1; }
  else if (s == 1) { op0 = 1; nops = 2; }
  else if (s == 3) { op0 = 3; nops = 2; }
  else if (s == 4) { op0 = 5; nops = 1; }
  else if (s == 5) { op0 = 6; nops = 1; }
  for (int i = 0; i < nops; ++i) {
    GemmDesc d;
    make_desc(d, p, l, op0 + i);
    gemm_phase(cx, d, op0 + i, p, l, smem);
  }

  if (s == 2) { scan_pass(cx, p, l); attn_phase(cx, p, smem); }
  if (s == 6) layernorm_pass(cx, p, l);
}

__global__ void __launch_bounds__(NTHR, 2) hymba_megakernel(Params p) {
  __shared__ __attribute__((aligned(16))) char smem[SMEM_BYTES];
  cg::grid_group grid = cg::this_grid();
  for (int ph = p.phase_lo; ph < p.phase_hi; ++ph) {
    run_phase(p, ph, smem);
    if (ph + 1 < p.phase_hi) grid.sync();
  }
}

#ifndef MULTI_LAUNCH
#define MULTI_LAUNCH 0
#endif

extern "C" void kernel_launch(void* const* d_in, const int* in_sizes, int n_in, void* d_out, int out_size, void* d_ws, size_t ws_size,
                              hipStream_t stream) {
  static int grid_blocks = 0;
  if (!grid_blocks) {
    int dev = 0, cus = 0, per_cu = 0;
    hipGetDevice(&dev);
    hipDeviceGetAttribute(&cus, hipDeviceAttributeMultiprocessorCount, dev);
    hipOccupancyMaxActiveBlocksPerMultiprocessor(&per_cu, hymba_megakernel, NTHR, 0);
    if (per_cu > 1) per_cu = 1;
    if (per_cu < 1) per_cu = 1;
    grid_blocks = cus * per_cu;
  }
  Params p{};
  p.x = (const float*)d_in[0]; p.w_in = (const float*)d_in[1]; p.kvg = (const float*)d_in[2]; p.w_uk = (const float*)d_in[3];
  p.w_uv = (const float*)d_in[4]; p.log_dt = (const float*)d_in[5]; p.a_re = (const float*)d_in[6]; p.a_im = (const float*)d_in[7];
  p.b_re = (const float*)d_in[8]; p.b_im = (const float*)d_in[9]; p.c_re = (const float*)d_in[10]; p.c_im = (const float*)d_in[11];
  p.d_skip = (const float*)d_in[12]; p.w_glu = (const float*)d_in[13]; p.b_glu = (const float*)d_in[14]; p.w_out = (const float*)d_in[15];
  p.ln_g = (const float*)d_in[16]; p.ln_b = (const float*)d_in[17];
  p.out = (float*)d_out; p.ws = (char*)d_ws;
  const int nph = 1 + 7 * DEPTH;
#if MULTI_LAUNCH
  for (int ph = 0; ph < nph; ++ph) {
    p.phase_lo = ph; p.phase_hi = ph + 1;
    hipLaunchKernelGGL(hymba_megakernel, dim3(grid_blocks), dim3(NTHR), 0, stream, p);
  }
#else
  p.phase_lo = 0; p.phase_hi = nph;
  void* args[] = {&p};
  hipError_t e = hipLaunchCooperativeKernel((void*)hymba_megakernel, dim3(grid_blocks), dim3(NTHR), args, 0, stream);
  if (e != hipSuccess) fprintf(stderr, "cooperative launch failed: %s (grid %d)\n", hipGetErrorString(e), grid_blocks);
#endif
}
```

```cpp
#include <hip/hip_runtime.h>
#include <hip/hip_bf16.h>
#include <hip/hip_cooperative_groups.h>
#include <cstdio>
namespace cg = cooperative_groups;

typedef __attribute__((ext_vector_type(8))) short bf16x8;
typedef __attribute__((ext_vector_type(4))) short s16x4;
typedef __attribute__((ext_vector_type(4))) float f32x4;
typedef __attribute__((ext_vector_type(16))) float f32x16;
typedef unsigned short u16;
typedef unsigned long long u64;

#define NTOK 65536
#define SEQL 4096
#define NBATCH 16
#define DM 1024
#define DIN 2472
#define NPAD 2560
#define DEPTH 4
#define NGRP 32
#define TCH 16
#define NCHUNK 4096
#define ALPHA 1.681792830507429f
#define SMEM_BYTES 151552
#define NTHR 512
#define NWV 8
#define REG_STRIDE 18944
#define KROW 272

#define MiB (1024ull * 1024ull)
#define OFF_XB    (0ull)
#define OFF_QB    (128 * MiB)
#define OFF_CKV   (192 * MiB)
#define OFF_CN    (224 * MiB)
#define OFF_QI    (240 * MiB)
#define OFF_KI    (272 * MiB)
#define OFF_WI    (276 * MiB)
#define OFF_SGA   (278 * MiB)
#define OFF_SGS   (342 * MiB)
#define OFF_UGM   (406 * MiB)
#define OFF_QL    (470 * MiB)
#define OFF_S     (598 * MiB)
#define OFF_STATS (662 * MiB)
#define OFF_WINT  (663 * MiB)
#define OFF_WOUTT (683 * MiB)
#define OFF_WGLUT (691 * MiB)
#define OFF_WUK   (695 * MiB)
#define OFF_WUVP  (696 * MiB)
#define OFF_OP1   (697 * MiB)
#define OFF_OP2   (705 * MiB)
#define OFF_AT    (729 * MiB)

struct Params {
  const float *x, *w_in, *kvg, *w_uk, *w_uv, *log_dt, *a_re, *a_im, *b_re, *b_im, *c_re, *c_im, *d_skip, *w_glu, *b_glu, *w_out, *ln_g, *ln_b;
  float* out;
  char* ws;
  int phase_lo, phase_hi;
};

struct Ctx { int tid, bid, G; };
#define OPAQUE_V(x) asm volatile("" : "+v"(x))
#define OPAQUE_S(x) asm volatile("" : "+s"(x))

__device__ __forceinline__ u16 f2bf(float f) {
  unsigned u = __float_as_uint(f);
  u += 0x7fffu + ((u >> 16) & 1u);
  return (u16)(u >> 16);
}
__device__ __forceinline__ float bf2f(u16 h) { return __uint_as_float(((unsigned)h) << 16); }
typedef __attribute__((ext_vector_type(2))) __bf16 bf16x2_t;
typedef __attribute__((ext_vector_type(2))) float f32x2_t;
__device__ __forceinline__ unsigned pack2(float a, float b) {
  f32x2_t v = {a, b};
  bf16x2_t r = __builtin_convertvector(v, bf16x2_t);
  return *(unsigned*)&r;
}
__device__ __forceinline__ float sigmoid_fast(float v) { return __builtin_amdgcn_rcpf(1.f + __builtin_amdgcn_exp2f(-1.4426950408889634f * v)); }
__device__ __forceinline__ float silu_f(float v) { return v * sigmoid_fast(v); }
__device__ __forceinline__ float gelu_tanh(float y) {
  float t = 0.7978845608028654f * (y + 0.044715f * y * y * y);
  return y * sigmoid_fast(2.f * t);
}

struct GemmDesc {
  const u16* A; const u16* A2; const u16* Bt;
  long a_bs, a2_bs, b_bs;
  int lda, lda2, ldb, ksplit;
  int M, N, K, nbatch;
};

#define LDT 72
#define CLD 132

__device__ __forceinline__ void run_epilogue(const Params& p, int l, int epi, int b, int row0, int col0, int tid, const float* sC, int ncols);

__device__ __forceinline__ void gemm_phase(const Ctx& cx, const GemmDesc& d, int epi, const Params& p, int l, char* smem) {
  const int tid = cx.tid, lane = tid & 63, wid = __builtin_amdgcn_readfirstlane(tid >> 6), wr = wid >> 2, wc = wid & 3;
  const int nM = d.M >> 8, nN = (d.N + 255) >> 8, nk = d.K >> 6;
  const int T = d.nbatch * nM * nN;
  const int G = cx.G, bid = cx.bid;
  int start, step, end;
  if ((G & 7) == 0) {
    int per = G >> 3, chunk = (T + 7) >> 3, xcd = bid & 7;
    start = xcd * chunk + (bid >> 3); step = per; end = min(T, (xcd + 1) * chunk);
  } else { start = bid; step = G; end = T; }
  const int lrow = lane >> 3;
  const int lsrc0 = ((lane & 7) ^ ((lane >> 4) & 7)) * 8;
  const int lsrc1 = ((lane & 7) ^ ((4 + (lane >> 4)) & 7)) * 8;
  const int fsw = (lane >> 1) & 7;
  const int ncols = min(256, d.N);
  const bool active = wc * 64 < ncols;
  bool prefetched = false;
  for (int t = start; t < end; t += step) {
#define TILE_DECODE(t_, m_, n_, b_, Ab_, A2b_, Bb_) do { \
      const int grp_ = (t_) / (4 * nN), rem_ = (t_) - grp_ * (4 * nN); \
      n_ = rem_ >> 2; const int r_ = grp_ * 4 + (rem_ & 3); m_ = r_ % nM; b_ = r_ / nM; \
      Ab_ = d.A + (long)b_ * d.a_bs + (long)(m_ * 256) * d.lda; \
      A2b_ = d.A2 ? d.A2 + (long)b_ * d.a2_bs + (long)(m_ * 256) * d.lda2 : nullptr; \
      Bb_ = d.Bt + (long)b_ * d.b_bs + (long)(n_ * 256) * d.ldb; \
    } while (0)
    int m, n, b; const u16 *Ab, *A2b, *Bb;
    TILE_DECODE(t, m, n, b, Ab, A2b, Bb);
    f32x4 acc[8][4];
#pragma unroll
    for (int i = 0; i < 8; ++i)
#pragma unroll
      for (int j = 0; j < 4; ++j) acc[i][j] = (f32x4){0.f, 0.f, 0.f, 0.f};
#define STAGE(kt_, s_) do { \
      const int k0_ = (kt_) * 64; \
      const u16* ap_; long ld_; \
      if (k0_ < d.ksplit) { ap_ = Ab + k0_; ld_ = d.lda; } else { ap_ = A2b + (k0_ - d.ksplit); ld_ = d.lda2; } \
      char* sa_ = smem + (s_) * 65536; \
      _Pragma("unroll") for (int j = 0; j < 4; ++j) { \
        const int g_ = wid * 4 + j;     \
        const int ls_ = (j & 1) ? lsrc1 : lsrc0; \
        __builtin_amdgcn_global_load_lds((const unsigned*)(ap_ + (long)(g_ * 8 + lrow) * ld_ + ls_), \
                                         (unsigned*)(sa_ + g_ * 1024 + lane * 16), 16, 0, 0); \
        const int br_ = (g_ * 8 + lrow) & (ncols - 1);     \
        __builtin_amdgcn_global_load_lds((const unsigned*)(Bb + (long)br_ * d.ldb + k0_ + ls_), \
                                         (unsigned*)(sa_ + 32768 + g_ * 1024 + lane * 16), 16, 0, 0); \
      } \
    } while (0)
    __syncthreads();
    if (!prefetched) STAGE(0, 0);
    asm volatile("s_waitcnt vmcnt(0)" ::: "memory");
    __builtin_amdgcn_s_barrier();
    const int arow = (wr * 128 + (lane & 15)) * 128, brow = 32768 + (wc * 64 + (lane & 15)) * 128;
    for (int kt = 0; kt < nk; ++kt) {
      const int s = kt & 1;
      if (kt + 1 < nk) STAGE(kt + 1, s ^ 1);
      if (active) {
        const char* sb = smem + s * 65536;
#pragma unroll 1
        for (int kh = 0; kh < 2; ++kh) {
          bf16x8 fa[8], fb[4];
          const int co = (((4 * kh + (lane >> 4)) ^ fsw) * 16);
#pragma unroll
          for (int nt = 0; nt < 4; ++nt) fb[nt] = *(const bf16x8*)(sb + brow + nt * 16 * 128 + co);
          fa[0] = *(const bf16x8*)(sb + arow + co);
          fa[1] = *(const bf16x8*)(sb + arow + 16 * 128 + co);
          __builtin_amdgcn_sched_barrier(0);
          acc[0][0] = __builtin_amdgcn_mfma_f32_16x16x32_bf16(fb[0], fa[0], acc[0][0], 0, 0, 0);
          __builtin_amdgcn_sched_barrier(0);
#pragma unroll
          for (int mt = 2; mt < 8; ++mt) fa[mt] = *(const bf16x8*)(sb + arow + mt * 16 * 128 + co);
          __builtin_amdgcn_sched_barrier(0);
#pragma unroll
          for (int nt = 1; nt < 4; ++nt)
            acc[0][nt] = __builtin_amdgcn_mfma_f32_16x16x32_bf16(fb[nt], fa[0], acc[0][nt], 0, 0, 0);
#pragma unroll
          for (int nt = 0; nt < 4; ++nt)
            acc[1][nt] = __builtin_amdgcn_mfma_f32_16x16x32_bf16(fb[nt], fa[1], acc[1][nt], 0, 0, 0);
          __builtin_amdgcn_sched_barrier(0);
#pragma unroll
          for (int mt = 2; mt < 8; ++mt)
#pragma unroll
            for (int nt = 0; nt < 4; ++nt)
              acc[mt][nt] = __builtin_amdgcn_mfma_f32_16x16x32_bf16(fb[nt], fa[mt], acc[mt][nt], 0, 0, 0);
          __builtin_amdgcn_sched_barrier(0);
        }
      }
      asm volatile("s_waitcnt vmcnt(0)" ::: "memory");
      __builtin_amdgcn_s_barrier();
    }
    const int m_cur = m, n_cur = n, b_cur = b;
    prefetched = false;
    if (t + step < end && (nk & 1) == 0) {
      TILE_DECODE(t + step, m, n, b, Ab, A2b, Bb);
      STAGE(0, 0);
      prefetched = true;
    }
    float* sC = (float*)(smem + 65536);
#pragma unroll
    for (int q = 0; q < 2; ++q)
#pragma unroll
      for (int ch = 0; ch < 2; ++ch) {
        if (ch * 128 < ncols) {
          if (q | ch) __syncthreads();
          if (active && (wc >> 1) == ch) {
#pragma unroll
            for (int mt2 = 0; mt2 < 4; ++mt2)
#pragma unroll
              for (int nt = 0; nt < 4; ++nt)
                *(f32x4*)(sC + (wr * 64 + mt2 * 16 + (lane & 15)) * CLD + (wc & 1) * 64 + nt * 16 + 4 * (lane >> 4)) = acc[4 * q + mt2][nt];
          }
          __syncthreads();
          run_epilogue(p, l, epi, b_cur, m_cur * 256 + q * 64, n_cur * 256 + ch * 128, tid, sC, 128);
        }
      }
  }
}

__device__ __forceinline__ uint2 pack4(float4 v) {
  uint2 pk;
  pk.x = pack2(v.x, v.y);
  pk.y = pack2(v.z, v.w);
  return pk;
}
__device__ __forceinline__ float4 unpack4(uint2 u) {
  float4 v;
  v.x = __uint_as_float(u.x << 16); v.y = __uint_as_float(u.x & 0xffff0000u);
  v.z = __uint_as_float(u.y << 16); v.w = __uint_as_float(u.y & 0xffff0000u);
  return v;
}
template <class F>
__device__ __forceinline__ void epi_each(int row0, int col0, int tid, const float* sC, int ncols, const F& f) {
#pragma unroll 2
  for (int j = 0; j < 8; ++j) {
    const int e = tid + NTHR * j;
    const int r = e >> 5, c = (e & 31) * 4;
    const float4 v = *(const float4*)(sC + r * CLD + c);
    f(row0 + r + (r & 64), col0 + c, v);
  }
}

struct EpiInProj {
  u16 *qb, *qi, *ki, *sga, *sgs, *ugm, *cn; float *wi; const float* kvg;
  __device__ __forceinline__ void run(int b, int row0, int col0, int tid, const float* sC, int ncols) const {
    const EpiInProj& s = *this;
    if (col0 == 512) {
      const int lane = tid & 63;
      const float4 gv = *(const float4*)(s.kvg + (lane & 31) * 4);
#pragma unroll 2
      for (int j = 0; j < 8; ++j) {
        const int e = tid + NTHR * j;
        const int r = e >> 5, c = (e & 31) * 4;
        const float4 v = *(const float4*)(sC + r * CLD + c);
        const long row = row0 + r + (r & 64);
        float ss = v.x * v.x + v.y * v.y + v.z * v.z + v.w * v.w;
        ss += __shfl_xor(ss, 16); ss += __shfl_xor(ss, 8); ss += __shfl_xor(ss, 4); ss += __shfl_xor(ss, 2); ss += __shfl_xor(ss, 1);
        const float rs = rsqrtf(ss * (1.f / 128.f) + 1e-6f);
        float4 w; w.x = v.x * rs * gv.x; w.y = v.y * rs * gv.y; w.z = v.z * rs * gv.z; w.w = v.w * rs * gv.w;
        *(uint2*)(s.cn + row * 128 + c) = pack4(w);
      }
      return;
    }
    epi_each(row0, col0, tid, sC, ncols, [&](int row, int col, float4 v) {
      if (col < 512) *(uint2*)(s.qb + (long)row * 512 + col) = pack4(v);
      else if (col < 896) *(uint2*)(s.qi + (long)row * 256 + (col - 640)) = pack4(v);
      else if (col < 928) *(uint2*)(s.ki + (long)row * 32 + (col - 896)) = pack4(v);
      else if (col < 936) { float4 w = v; w.x *= 0.0625f; w.y *= 0.0625f; w.z *= 0.0625f; w.w *= 0.0625f; *(float4*)(s.wi + (long)row * 8 + (col - 928)) = w; }
      else if (col < 1024) {}
      else if (col < 1536) { float4 w; w.x = silu_f(v.x); w.y = silu_f(v.y); w.z = silu_f(v.z); w.w = silu_f(v.w); *(uint2*)(s.sga + (long)row * 512 + (col - 1024)) = pack4(w); }
      else if (col < 2048) { int cc = col - 1536; *(uint2*)(s.ugm + ((long)(cc >> 4) * NTOK + row) * 16 + (cc & 15)) = pack4(v); }
      else { float4 w; w.x = silu_f(v.x); w.y = silu_f(v.y); w.z = silu_f(v.z); w.w = silu_f(v.w); *(uint2*)(s.sgs + (long)row * 512 + (col - 2048)) = pack4(w); }
    });
  }
};
struct EpiQlat {
  u16* ql;
  __device__ __forceinline__ void run(int b, int row0, int col0, int tid, const float* sC, int ncols) const {
    u16* o = ql;
    epi_each(row0, col0, tid, sC, ncols, [&](int row, int col, float4 v) { *(uint2*)(o + (long)row * 1024 + b * 128 + col) = pack4(v); });
  }
};
struct EpiS {
  float* S;
  __device__ __forceinline__ void run(int b, int row0, int col0, int tid, const float* sC, int ncols) const {
    float* o = S;
    epi_each(row0, col0, tid, sC, ncols, [&](int row, int col, float4 v) { *(float4*)(o + ((long)b * NCHUNK + row) * 128 + col) = v; });
  }
};
struct EpiUv {
  const u16* sga; u16* mixed;
  __device__ __forceinline__ void run(int b, int row0, int col0, int tid, const float* sC, int ncols) const {
    const u16* g = sga; u16* o = mixed;
    epi_each(row0, col0, tid, sC, ncols, [&](int row, int col, float4 v) {
      int c2 = b * 128 + col;
      float4 gv = unpack4(*(const uint2*)(g + (long)row * 512 + c2));
      float4 w; w.x = v.x * gv.x; w.y = v.y * gv.y; w.z = v.z * gv.z; w.w = v.w * gv.w;
      *(uint2*)(o + (long)row * 1024 + c2) = pack4(w);
    });
  }
};
struct EpiY {
  const u16* ugm; const float* dsk; u16* yact;
  __device__ __forceinline__ void run(int b, int row0, int col0, int tid, const float* sC, int ncols) const {
    const u16* u = ugm; const float* dd = dsk; u16* o = yact;
    epi_each(row0, col0, tid, sC, ncols, [&](int row, int col, float4 v) {
      int t = col >> 4, c = col & 15;
      long token = (long)row * TCH + t;
      float4 uv = unpack4(*(const uint2*)(u + ((long)b * NTOK + token) * 16 + c));
      float4 dv = *(const float4*)(dd + b * 16 + c);
      float4 w;
      w.x = gelu_tanh(v.x + dv.x * uv.x); w.y = gelu_tanh(v.y + dv.y * uv.y);
      w.z = gelu_tanh(v.z + dv.z * uv.z); w.w = gelu_tanh(v.w + dv.w * uv.w);
      *(uint2*)(o + token * 512 + b * 16 + c) = pack4(w);
    });
  }
};
struct EpiGlu {
  const u16* sgs; const float* bglu; u16* mixed;
  __device__ __forceinline__ void run(int b, int row0, int col0, int tid, const float* sC, int ncols) const {
#pragma unroll 2
    for (int jj = 0; jj < 4; ++jj) {
      const int e = tid + NTHR * jj;
      const int r = e >> 4, q = e & 15, gi = q >> 3, qq = q & 7;
      const float4 va = *(const float4*)(sC + r * CLD + gi * 64 + qq * 4);
      const float4 ga = *(const float4*)(sC + r * CLD + gi * 64 + 32 + qq * 4);
      const int j = (col0 >> 1) + gi * 32 + qq * 4;
      const long row = row0 + r + (r & 64);
      const float4 bv = *(const float4*)(bglu + j), bg = *(const float4*)(bglu + 512 + j);
      const float4 sg = unpack4(*(const uint2*)(sgs + row * 512 + j));
      float4 w;
      w.x = (va.x + bv.x) * sigmoid_fast(ga.x + bg.x) * sg.x;
      w.y = (va.y + bv.y) * sigmoid_fast(ga.y + bg.y) * sg.y;
      w.z = (va.z + bv.z) * sigmoid_fast(ga.z + bg.z) * sg.z;
      w.w = (va.w + bv.w) * sigmoid_fast(ga.w + bg.w) * sg.w;
      *(uint2*)(mixed + row * 1024 + 512 + j) = pack4(w);
    }
  }
};
struct EpiOut {
  const float* xin; float* z; const float* stats; const float* g; const float* bb; int first;
  __device__ __forceinline__ void run(int b, int row0, int col0, int tid, const float* sC, int ncols) const {
    const EpiOut& s = *this;
    epi_each(row0, col0, tid, sC, ncols, [&](int row, int col, float4 v) {
      long idx = (long)row * 1024 + col;
      float4 xp;
      if (s.first) xp = *(const float4*)(s.xin + idx);
      else {
        float mu = s.stats[2 * row], rs = s.stats[2 * row + 1];
        float4 zo = *(const float4*)(s.z + idx), gv = *(const float4*)(s.g + col), bv = *(const float4*)(s.bb + col);
        xp.x = (zo.x - mu) * rs * gv.x + bv.x; xp.y = (zo.y - mu) * rs * gv.y + bv.y;
        xp.z = (zo.z - mu) * rs * gv.z + bv.z; xp.w = (zo.w - mu) * rs * gv.w + bv.w;
      }
      float4 o; o.x = ALPHA * xp.x + v.x; o.y = ALPHA * xp.y + v.y; o.z = ALPHA * xp.z + v.z; o.w = ALPHA * xp.w + v.w;
      *(float4*)(s.z + idx) = o;
    });
  }
};

template <class CM>
__device__ __forceinline__ void transpose_tile(const Ctx& cx, const float* src, int sld, u16* dst, int dld, int k0, int n0, const CM& colmap, char* smem) {
  float* tile = (float*)smem;
  const int tid = cx.tid;
  __syncthreads();
  for (int e = tid; e < 4096; e += NTHR) {
    int kk = e >> 6, nn = e & 63;
    int sc = colmap(n0 + nn);
    tile[kk * 65 + nn] = sc >= 0 ? src[(long)(k0 + kk) * sld + sc] : 0.f;
  }
  __syncthreads();
  for (int e = tid; e < 4096; e += NTHR) {
    int nn = e >> 6, kk = e & 63;
    dst[(long)(n0 + nn) * dld + k0 + kk] = f2bf(tile[kk * 65 + nn]);
  }
}

__device__ __forceinline__ void ssm_ops(const Ctx& cx, const Params& p, int l, int g, char* smem) {
  float* ap = (float*)smem;
  float* bbm = ap + 17 * 64 * 2;
  float* ccm = bbm + 64 * 16 * 2;
  float* kj = ccm + 16 * 64 * 2;
  const int tid = cx.tid;
  const int lg = l * NGRP + g;
  __syncthreads();
  if (tid < 64) {
    const int pp = tid;
    float dt = expf(p.log_dt[lg]);
    float lr = p.a_re[lg * 64 + pp], li = p.a_im[lg * 64 + pp];
    for (int j = 0; j <= 16; ++j) {
      float mag = expf(lr * dt * (float)j);
      float sn, cs; sincosf(li * dt * (float)j, &sn, &cs);
      ap[(j * 64 + pp) * 2] = mag * cs; ap[(j * 64 + pp) * 2 + 1] = mag * sn;
    }
    float ar = ap[(1 * 64 + pp) * 2], ai = ap[(1 * 64 + pp) * 2 + 1];
    float den = lr * lr + li * li;
    float cr = ((ar - 1.f) * lr + ai * li) / den;
    float ci = (ai * lr - (ar - 1.f) * li) / den;
    for (int c = 0; c < 16; ++c) {
      float br = p.b_re[((long)lg * 64 + pp) * 16 + c], bi = p.b_im[((long)lg * 64 + pp) * 16 + c];
      bbm[(pp * 16 + c) * 2] = cr * br - ci * bi;
      bbm[(pp * 16 + c) * 2 + 1] = cr * bi + ci * br;
    }
    float* at = (float*)(p.ws + OFF_AT) + ((long)lg * 64 + pp) * 2;
    at[0] = ap[(16 * 64 + pp) * 2]; at[1] = ap[(16 * 64 + pp) * 2 + 1];
  }
  for (int e = tid; e < 1024; e += NTHR) {
    ccm[e * 2] = p.c_re[(long)lg * 1024 + e];
    ccm[e * 2 + 1] = p.c_im[(long)lg * 1024 + e];
  }
  __syncthreads();
  for (int e = tid; e < 4096; e += NTHR) {
    int j = e >> 8, cp = (e >> 4) & 15, c = e & 15;
    float s = 0.f;
    for (int pp = 0; pp < 64; ++pp) {
      float c_r = ccm[(cp * 64 + pp) * 2], c_i = ccm[(cp * 64 + pp) * 2 + 1];
      float a_r = ap[(j * 64 + pp) * 2], a_i = ap[(j * 64 + pp) * 2 + 1];
      float er = c_r * a_r - c_i * a_i, ei = c_r * a_i + c_i * a_r;
      s += er * bbm[(pp * 16 + c) * 2] - ei * bbm[(pp * 16 + c) * 2 + 1];
    }
    kj[e] = s;
  }
  __syncthreads();
  u16* op2 = (u16*)(p.ws + OFF_OP2) + (long)lg * 256 * 384;
  for (int e = tid; e < 256 * 384; e += NTHR) {
    int n = e / 384, k = e - n * 384;
    int t = n >> 4, cp = n & 15;
    float v;
    if (k < 256) {
      int s = k >> 4, c = k & 15;
      v = (s <= t) ? kj[((t - s) * 16 + cp) * 16 + c] : 0.f;
    } else {
      int j = k - 256, pp = j & 63;
      float c_r = ccm[(cp * 64 + pp) * 2], c_i = ccm[(cp * 64 + pp) * 2 + 1];
      float a_r = ap[((t + 1) * 64 + pp) * 2], a_i = ap[((t + 1) * 64 + pp) * 2 + 1];
      v = (j < 64) ? (c_r * a_r - c_i * a_i) : -(c_r * a_i + c_i * a_r);
    }
    op2[e] = f2bf(v);
  }
  u16* op1 = (u16*)(p.ws + OFF_OP1) + (long)lg * 128 * 256;
  for (int e = tid; e < 128 * 256; e += NTHR) {
    int j = e >> 8, k = e & 255;
    int pp = j & 63, s = k >> 4, c = k & 15;
    float a_r = ap[((15 - s) * 64 + pp) * 2], a_i = ap[((15 - s) * 64 + pp) * 2 + 1];
    float b_r = bbm[(pp * 16 + c) * 2], b_i = bbm[(pp * 16 + c) * 2 + 1];
    float v = (j < 64) ? (a_r * b_r - a_i * b_i) : (a_r * b_i + a_i * b_r);
    op1[e] = f2bf(v);
  }
}

__device__ __forceinline__ void prologue_phase(const Ctx& cx, const Params& p, char* smem) {
  const int G = cx.G, bid = cx.bid, tid = cx.tid;
  for (int it = bid; it < DEPTH * NGRP; it += G) ssm_ops(cx, p, it / NGRP, it % NGRP, smem);
  for (int it = bid; it < DEPTH * 16 * 40; it += G) {
    int l = it / 640, r = it % 640, kt = r / 40, ntile = r % 40;
    transpose_tile(cx, p.w_in + (long)l * DM * DIN, DIN, (u16*)(p.ws + OFF_WINT) + (long)l * NPAD * DM, DM, kt * 64, ntile * 64,
                   [](int n) { return n < 936 ? n : (n < 1024 ? -1 : n - 88); }, smem);
  }
  for (int it = bid; it < DEPTH * 256; it += G) {
    int l = it >> 8, r = it & 255, kt = r >> 4, ntile = r & 15;
    transpose_tile(cx, p.w_out + (long)l * DM * DM, DM, (u16*)(p.ws + OFF_WOUTT) + (long)l * DM * DM, DM, kt * 64, ntile * 64,
                   [](int n) { return n; }, smem);
  }
  for (int it = bid; it < DEPTH * 128; it += G) {
    int l = it >> 7, r = it & 127, kt = r >> 4, ntile = r & 15;
    transpose_tile(cx, p.w_glu + (long)l * 512 * 1024, 1024, (u16*)(p.ws + OFF_WGLUT) + (long)l * 1024 * 512, 512, kt * 64, ntile * 64,
                   [](int n) { return ((n >> 5) & 1) * 512 + (n >> 6) * 32 + (n & 31); }, smem);
  }
  const long gtid = (long)bid * NTHR + tid, gsz = (long)G * NTHR;
  {
    u16* o = (u16*)(p.ws + OFF_WUK);
    for (long e = gtid; e < (long)DEPTH * 8 * 128 * 64; e += gsz) o[e] = f2bf(0.125f * 1.4426950408889634f * p.w_uk[e]);
  }
  {
    u16* o = (u16*)(p.ws + OFF_WUVP);
    for (long e = gtid; e < (long)DEPTH * 4 * 128 * 256; e += gsz) {
      int k = e & 255, n = (e >> 8) & 127, j = (e >> 15) & 3, l = (int)(e >> 17);
      int hh = n >> 6, dd = n & 63, hh2 = k >> 7, c = k & 127;
      float v = (hh == hh2) ? p.w_uv[(((long)l * 8 + 2 * j + hh) * 128 + c) * 64 + dd] : 0.f;
      o[e] = f2bf(v);
    }
  }
  {
    u16* o = (u16*)(p.ws + OFF_XB);
    const float4* xi = (const float4*)p.x;
    for (long e = gtid; e < (long)NTOK * DM / 4; e += gsz) {
      float4 v = xi[e];
      uint2 pk;
      pk.x = pack2(v.x, v.y);
      pk.y = pack2(v.z, v.w);
      *(uint2*)(o + e * 4) = pk;
    }
  }
}

__device__ __forceinline__ void rmsnorm_pass(const Ctx& cx, const Params& p, int l) {
  const float* ckv = (const float*)(p.ws + OFF_CKV);
  u16* cn = (u16*)(p.ws + OFF_CN);
  const float* g = p.kvg + l * 128;
  const int lane = cx.tid & 63, half = lane >> 5, l32 = lane & 31;
  const long gw = (long)cx.bid * NWV + (cx.tid >> 6), nw = (long)cx.G * NWV;
  const float4 gv = *(const float4*)(g + l32 * 4);
  for (long it = gw; it < NTOK / 2; it += nw) {
    long tok = it * 2 + half;
    float4 v = *(const float4*)(ckv + tok * 128 + l32 * 4);
    float ss = v.x * v.x + v.y * v.y + v.z * v.z + v.w * v.w;
    ss += __shfl_xor(ss, 16); ss += __shfl_xor(ss, 8); ss += __shfl_xor(ss, 4); ss += __shfl_xor(ss, 2); ss += __shfl_xor(ss, 1);
    float rs = rsqrtf(ss * (1.f / 128.f) + 1e-6f);
    uint2 pk;
    pk.x = pack2(v.x * rs * gv.x, v.y * rs * gv.y);
    pk.y = pack2(v.z * rs * gv.z, v.w * rs * gv.w);
    *(uint2*)(cn + tok * 128 + l32 * 4) = pk;
  }
}

__device__ __forceinline__ void layernorm_pass(const Ctx& cx, const Params& p, int l) {
  float* z = p.out;
  float* stats = (float*)(p.ws + OFF_STATS);
  u16* xb = (u16*)(p.ws + OFF_XB);
  const float* g = p.ln_g + l * DM; const float* bb = p.ln_b + l * DM;
  const int lane = cx.tid & 63;
  const long gw = (long)cx.bid * NWV + (cx.tid >> 6), nw = (long)cx.G * NWV;
  float4 gv[4], bv[4];
#pragma unroll
  for (int j = 0; j < 4; ++j) { gv[j] = *(const float4*)(g + j * 256 + lane * 4); bv[j] = *(const float4*)(bb + j * 256 + lane * 4); }
  for (long row = gw; row < NTOK; row += nw) {
    float4 v[4];
    float s = 0.f;
#pragma unroll
    for (int j = 0; j < 4; ++j) { v[j] = *(const float4*)(z + row * DM + j * 256 + lane * 4); s += v[j].x + v[j].y + v[j].z + v[j].w; }
#pragma unroll
    for (int o = 32; o >= 1; o >>= 1) s += __shfl_xor(s, o);
    float mu = s * (1.f / 1024.f);
    float q = 0.f;
#pragma unroll
    for (int j = 0; j < 4; ++j) {
      float a = v[j].x - mu, b = v[j].y - mu, c = v[j].z - mu, d = v[j].w - mu;
      q += a * a + b * b + c * c + d * d;
    }
#pragma unroll
    for (int o = 32; o >= 1; o >>= 1) q += __shfl_xor(q, o);
    float rs = rsqrtf(q * (1.f / 1024.f) + 1e-5f);
    if (l == DEPTH - 1) {
#pragma unroll
      for (int j = 0; j < 4; ++j) {
        float4 o;
        o.x = (v[j].x - mu) * rs * gv[j].x + bv[j].x; o.y = (v[j].y - mu) * rs * gv[j].y + bv[j].y;
        o.z = (v[j].z - mu) * rs * gv[j].z + bv[j].z; o.w = (v[j].w - mu) * rs * gv[j].w + bv[j].w;
        *(float4*)(z + row * DM + j * 256 + lane * 4) = o;
      }
    } else {
      if (lane == 0) { stats[2 * row] = mu; stats[2 * row + 1] = rs; }
#pragma unroll
      for (int j = 0; j < 4; ++j) {
        float a = (v[j].x - mu) * rs * gv[j].x + bv[j].x, b = (v[j].y - mu) * rs * gv[j].y + bv[j].y;
        float c = (v[j].z - mu) * rs * gv[j].z + bv[j].z, d = (v[j].w - mu) * rs * gv[j].w + bv[j].w;
        uint2 pk;
        pk.x = pack2(a, b);
        pk.y = pack2(c, d);
        *(uint2*)(xb + row * DM + j * 256 + lane * 4) = pk;
      }
    }
  }
}

__device__ __forceinline__ void scan_pass(const Ctx& cx, const Params& p, int l) {
  const float* S = (const float*)(p.ws + OFF_S);
  u16* Xin = (u16*)(p.ws + OFF_CKV);
  const int lane = cx.tid & 63;
  const int gw = cx.bid * NWV + (cx.tid >> 6), nw = cx.G * NWV;
  for (int it = gw; it < NBATCH * NGRP; it += nw) {
    int b = it >> 5, g = it & 31;
    const float* at = (const float*)(p.ws + OFF_AT) + ((long)(l * NGRP + g) * 64 + lane) * 2;
    const float ar = at[0], ai = at[1];
    float xr = 0.f, xi = 0.f;
    long row0 = (long)g * NCHUNK + b * 256;
    for (int k0 = 0; k0 < 256; k0 += 32) {
      float sr[32], si[32];
#pragma unroll
      for (int j = 0; j < 32; ++j) { sr[j] = S[(row0 + k0 + j) * 128 + lane]; si[j] = S[(row0 + k0 + j) * 128 + 64 + lane]; }
#pragma unroll
      for (int j = 0; j < 32; ++j) {
        Xin[(row0 + k0 + j) * 128 + lane] = f2bf(xr);
        Xin[(row0 + k0 + j) * 128 + 64 + lane] = f2bf(xi);
        float nr = ar * xr - ai * xi + sr[j];
        float ni = ar * xi + ai * xr + si[j];
        xr = nr; xi = ni;
      }
    }
  }
}

__device__ __forceinline__ unsigned sortable(float f) {
  unsigned u = __float_as_uint(f);
  return u ^ ((unsigned)((int)u >> 31) | 0x80000000u);
}
__device__ __forceinline__ int mbcnt64(u64 m) {
  return __builtin_amdgcn_mbcnt_hi((unsigned)(m >> 32), __builtin_amdgcn_mbcnt_lo((unsigned)m, 0));
}

__device__ __forceinline__ void attn_phase(const Ctx& cx, const Params& p, char* smem) {
  const u16* qi = (const u16*)(p.ws + OFF_QI);
  const u16* ki = (const u16*)(p.ws + OFF_KI);
  const float* wi = (const float*)(p.ws + OFF_WI);
  const u16* cn = (const u16*)(p.ws + OFF_CN);
  u16* ql = (u16*)(p.ws + OFF_QL);
  const int tid = cx.tid, lane = tid & 63, wid = __builtin_amdgcn_readfirstlane(tid >> 6);
  const int hh = lane >> 5;
  const int G = cx.G;
  for (int item = cx.bid; item < (SEQL / 8) * NBATCH; item += G) {
    const int tq = (SEQL / 8 - 1) - (item >> 4), b = item & 15;
    const int t0 = tq * 8;
    const long tokbase = (long)b * SEQL;
    {
      const int r = lane & 31;
      const int qq = 2 * ((r >> 2) & 1) + (r >> 4), head = (r & 3) + 4 * ((r >> 3) & 1);
      const u16* qip = qi + (tokbase + t0 + qq) * 256 + head * 32 + 8 * hh;
      const bf16x8 qa0 = *(const bf16x8*)qip, qa1 = *(const bf16x8*)(qip + 16);
      const bf16x8 qb0 = *(const bf16x8*)(qip + 4 * 256), qb1 = *(const bf16x8*)(qip + 4 * 256 + 16);
      float w0[8], w1[8], w2[8], w3[8];
      {
        const float4* wp = (const float4*)(wi + (tokbase + t0 + 2 * hh) * 8);
        float4 a = wp[0], bq = wp[1], c = wp[2], d = wp[3];
        w0[0] = a.x; w0[1] = a.y; w0[2] = a.z; w0[3] = a.w; w0[4] = bq.x; w0[5] = bq.y; w0[6] = bq.z; w0[7] = bq.w;
        w1[0] = c.x; w1[1] = c.y; w1[2] = c.z; w1[3] = c.w; w1[4] = d.x; w1[5] = d.y; w1[6] = d.z; w1[7] = d.w;
        const float4* wq = (const float4*)(wi + (tokbase + t0 + 4 + 2 * hh) * 8);
        a = wq[0]; bq = wq[1]; c = wq[2]; d = wq[3];
        w2[0] = a.x; w2[1] = a.y; w2[2] = a.z; w2[3] = a.w; w2[4] = bq.x; w2[5] = bq.y; w2[6] = bq.z; w2[7] = bq.w;
        w3[0] = c.x; w3[1] = c.y; w3[2] = c.z; w3[3] = c.w; w3[4] = d.x; w3[5] = d.y; w3[6] = d.z; w3[7] = d.w;
      }
      const int ntiles = ((t0 + 7) >> 5) + 1;
      const int q0 = t0 + 2 * hh;
      unsigned* sc0 = (unsigned*)(smem + (2 * hh) * REG_STRIDE);
      unsigned* sc1 = (unsigned*)(smem + (2 * hh + 1) * REG_STRIDE);
      unsigned* sc2 = (unsigned*)(smem + (4 + 2 * hh) * REG_STRIDE);
      unsigned* sc3 = (unsigned*)(smem + (4 + 2 * hh + 1) * REG_STRIDE);
      __syncthreads();
      bf16x8 nk0, nk1;
      {
        const u16* kp = ki + (tokbase + min(wid, ntiles - 1) * 32 + r) * 32 + 8 * hh;
        nk0 = *(const bf16x8*)kp; nk1 = *(const bf16x8*)(kp + 16);
      }
      for (int tile = wid; tile < ntiles; tile += NWV) {
        const int key = tile * 32 + r;
        const bf16x8 kb0 = nk0, kb1 = nk1;
        {
          const u16* kp = ki + (tokbase + min(tile + NWV, ntiles - 1) * 32 + r) * 32 + 8 * hh;
          nk0 = *(const bf16x8*)kp; nk1 = *(const bf16x8*)(kp + 16);
        }
        f32x16 acc, acd;
#pragma unroll
        for (int e = 0; e < 16; ++e) { acc[e] = 0.f; acd[e] = 0.f; }
        acc = __builtin_amdgcn_mfma_f32_32x32x16_bf16(qa0, kb0, acc, 0, 0, 0);
        acd = __builtin_amdgcn_mfma_f32_32x32x16_bf16(qb0, kb0, acd, 0, 0, 0);
        acc = __builtin_amdgcn_mfma_f32_32x32x16_bf16(qa1, kb1, acc, 0, 0, 0);
        acd = __builtin_amdgcn_mfma_f32_32x32x16_bf16(qb1, kb1, acd, 0, 0, 0);
        float s0 = 0.f, s1 = 0.f, s2 = 0.f, s3 = 0.f;
#pragma unroll
        for (int e = 0; e < 8; ++e) {
          s0 += w0[e] * fmaxf(acc[e], 0.f); s1 += w1[e] * fmaxf(acc[8 + e], 0.f);
          s2 += w2[e] * fmaxf(acd[e], 0.f); s3 += w3[e] * fmaxf(acd[8 + e], 0.f);
        }
        sc0[key] = (key <= q0) ? sortable(s0) : 0u;
        sc1[key] = (key <= q0 + 1) ? sortable(s1) : 0u;
        sc2[key] = (key <= q0 + 4) ? sortable(s2) : 0u;
        sc3[key] = (key <= q0 + 5) ? sortable(s3) : 0u;
      }
      __syncthreads();
    }
    const int t = t0 + wid;
    char* reg = smem + wid * REG_STRIDE;
    const unsigned* sc = (const unsigned*)reg;
    u16* sel = (u16*)(reg + 18432);
    const int nvalid = t + 1;
    int count;
    if (nvalid <= 256) {
      count = nvalid;
      for (int i = lane; i < 256; i += 64) sel[i] = (u16)(i < nvalid ? i : 0);
    } else {
      count = 256;
      unsigned v[64];
#pragma unroll
      for (int i = 0; i < 64; ++i) { int key = i * 64 + lane; v[i] = (key < nvalid) ? sc[key] : 0u; }
      const int ni = (nvalid + 63) >> 6;
#define CNT_GE(THR, CNT) do { \
        int c_ = 0; \
        _Pragma("unroll") for (int gq = 0; gq < 4; ++gq) { \
          if (gq * 16 < ni) { \
            _Pragma("unroll") for (int j = 0; j < 16; ++j) c_ += __builtin_popcountll(__ballot(v[gq * 16 + j] >= (THR))); \
          } \
        } \
        CNT = c_; } while (0)
      unsigned vmax = 0u;
#pragma unroll
      for (int i = 0; i < 64; ++i) vmax = max(vmax, v[i]);
#pragma unroll
      for (int o = 32; o >= 1; o >>= 1) vmax = max(vmax, (unsigned)__shfl_xor((int)vmax, o));
      vmax = (unsigned)__builtin_amdgcn_readfirstlane((int)vmax);
      unsigned lo = 0u, hi = vmax + 1u;
      int clo = 4096, chi = 0;
      bool positive = false;
      {
        int c0; CNT_GE(0x80000000u, c0);
        if (c0 >= 256) { lo = 0x80000000u; clo = c0; positive = true; }
        else { hi = 0x80000000u; chi = c0; }
      }
      while (clo != 256 && clo - chi > 128 && hi - lo > 1u) {
        unsigned mid = lo + ((hi - lo) >> 1);
        if (positive) {
          const float fm = 0.5f * (__uint_as_float(lo & 0x7fffffffu) + __uint_as_float(hi & 0x7fffffffu));
          const unsigned m2 = __float_as_uint(fm) | 0x80000000u;
          if (m2 > lo && m2 < hi) mid = m2;
        }
        int cnt; CNT_GE(mid, cnt);
        if (cnt >= 256) { lo = mid; clo = cnt; } else { hi = mid; chi = cnt; }
      }
      if (clo <= 384) {
        unsigned* dval = (unsigned*)(reg + 8192);
        u16* dkey = (u16*)(reg + 8192 + 1536);
        {
          int base = 0;
#pragma unroll
          for (int gq = 0; gq < 4; ++gq) {
            if (gq * 16 < ni) {
#pragma unroll
              for (int j = 0; j < 16; ++j) {
                const int i = gq * 16 + j;
                const bool in = v[i] >= lo;
                const u64 m = __ballot(in);
                if (in) { const int pos = base + mbcnt64(m); dval[pos] = v[i]; dkey[pos] = (u16)(i * 64 + lane); }
                base += __builtin_popcountll(m);
              }
            }
          }
        }
        unsigned dv[6]; int dk[6];
#pragma unroll
        for (int j = 0; j < 6; ++j) {
          const int idx = j * 64 + lane;
          dv[j] = (idx < clo) ? dval[idx] : 0u;
          dk[j] = (idx < clo) ? (int)dkey[idx] : 0;
        }
        while (clo != 256 && hi - lo > 1u) {
          const unsigned mid = lo + ((hi - lo) >> 1);
          int cnt = 0;
#pragma unroll
          for (int j = 0; j < 6; ++j) cnt += __builtin_popcountll(__ballot(dv[j] >= mid));
          if (cnt >= 256) { lo = mid; clo = cnt; } else { hi = mid; chi = cnt; }
        }
        int base = 0, eqleft = (clo == 256) ? 512 : 256 - chi;
#pragma unroll
        for (int j = 0; j < 6; ++j) {
          const bool gt = dv[j] > lo, eq = dv[j] == lo;
          const u64 meq = __ballot(eq);
          const bool take = gt || (eq && mbcnt64(meq) < eqleft);
          const u64 mt = __ballot(take);
          if (take) sel[base + mbcnt64(mt)] = (u16)dk[j];
          base += __builtin_popcountll(mt);
          eqleft -= min((int)__builtin_popcountll(meq), eqleft);
        }
      } else {
        int base = 0, eqleft = 256 - chi;
#pragma unroll
        for (int gq = 0; gq < 4; ++gq) {
          if (gq * 16 < ni) {
#pragma unroll
            for (int j = 0; j < 16; ++j) {
              const int i = gq * 16 + j;
              const bool gt = v[i] > lo, eq = v[i] == lo;
              const u64 meq = __ballot(eq);
              const bool take = gt || (eq && mbcnt64(meq) < eqleft);
              const u64 mt = __ballot(take);
              if (take) sel[base + mbcnt64(mt)] = (u16)(i * 64 + lane);
              base += __builtin_popcountll(mt);
              eqleft -= min((int)__builtin_popcountll(meq), eqleft);
              if ((j & 3) == 3) __builtin_amdgcn_sched_barrier(0);
            }
          }
        }
      }
    }
    {
      const long token = tokbase + t;
      const int hd = lane & 15, g4 = lane >> 4;
      bf16x8 qf[4];
#pragma unroll
      for (int ks = 0; ks < 4; ++ks) {
        if (hd < 8) qf[ks] = *(const bf16x8*)(ql + token * 1024 + hd * 128 + 32 * ks + 8 * g4);
        else { for (int e = 0; e < 8; ++e) qf[ks][e] = 0; }
      }
      const int nch = (count + 31) >> 5;
      f32x4 o[8];
#pragma unroll
      for (int c = 0; c < 8; ++c) o[c] = (f32x4){0.f, 0.f, 0.f, 0.f};
      float mrun = -1e30f, lsum = 0.f;
      const int qd = (lane & 15) >> 2, pq = lane & 3;
      bf16x8 kr[8];
#define LOADK32(JJ) do { \
        _Pragma("unroll") for (int j = 0; j < 8; ++j) { \
          const int key_ = sel[32 * (JJ) + 4 * j + g4]; \
          kr[j] = *(const bf16x8*)(cn + (tokbase + key_) * 128 + 8 * hd); \
        } } while (0)
      LOADK32(0);
      for (int jj = 0; jj < nch; ++jj) {
#pragma unroll
        for (int j = 0; j < 8; ++j) *(bf16x8*)(reg + (4 * j + g4) * KROW + hd * 16) = kr[j];
        __builtin_amdgcn_sched_barrier(0);
        if (jj + 1 < nch) LOADK32(jj + 1);
        __builtin_amdgcn_sched_barrier(0);
        f32x4 sacc[2];
#pragma unroll
        for (int tt = 0; tt < 2; ++tt) {
          sacc[tt] = (f32x4){0.f, 0.f, 0.f, 0.f};
#pragma unroll
          for (int ks = 0; ks < 4; ++ks) {
            const bf16x8 kfr = *(const bf16x8*)(reg + (16 * tt + hd) * KROW + (32 * ks + 8 * g4) * 2);
            sacc[tt] = __builtin_amdgcn_mfma_f32_16x16x32_bf16(kfr, qf[ks], sacc[tt], 0, 0, 0);
          }
        }
        if (32 * jj + 32 > count) {
#pragma unroll
          for (int tt = 0; tt < 2; ++tt)
#pragma unroll
            for (int i = 0; i < 4; ++i) {
              const int slot = 32 * jj + 16 * tt + 4 * g4 + i;
              if (slot >= count) sacc[tt][i] = -1e30f;
            }
        }
        float mloc = fmaxf(fmaxf(fmaxf(sacc[0][0], sacc[0][1]), fmaxf(sacc[0][2], sacc[0][3])),
                           fmaxf(fmaxf(sacc[1][0], sacc[1][1]), fmaxf(sacc[1][2], sacc[1][3])));
        mloc = fmaxf(mloc, __shfl_xor(mloc, 16));
        mloc = fmaxf(mloc, __shfl_xor(mloc, 32));
        const float mnew = fmaxf(mrun, mloc);
        const float alpha = __builtin_amdgcn_exp2f(mrun - mnew);
        mrun = mnew;
        float pv[8];
#pragma unroll
        for (int tt = 0; tt < 2; ++tt)
#pragma unroll
          for (int i = 0; i < 4; ++i) pv[tt * 4 + i] = __builtin_amdgcn_exp2f(sacc[tt][i] - mnew);
        const float ps = ((pv[0] + pv[1]) + (pv[2] + pv[3])) + ((pv[4] + pv[5]) + (pv[6] + pv[7]));
        bf16x8 pb;
        {
          unsigned* pw = (unsigned*)&pb;
          pw[0] = pack2(pv[0], pv[1]); pw[1] = pack2(pv[2], pv[3]); pw[2] = pack2(pv[4], pv[5]); pw[3] = pack2(pv[6], pv[7]);
        }
        lsum = lsum * alpha + ps;
#pragma unroll
        for (int c = 0; c < 8; ++c) { o[c][0] *= alpha; o[c][1] *= alpha; o[c][2] *= alpha; o[c][3] *= alpha; }
#pragma unroll
        for (int c = 0; c < 8; ++c) {
          const unsigned a_lo = (unsigned)(size_t)(reg) ;
          (void)a_lo;
          s16x4 lo = __builtin_amdgcn_ds_read_tr16_b64_v4i16(
              (s16x4 __attribute__((address_space(3)))*)(reg + (4 * g4 + qd) * KROW + (16 * c + 4 * pq) * 2));
          s16x4 hi = __builtin_amdgcn_ds_read_tr16_b64_v4i16(
              (s16x4 __attribute__((address_space(3)))*)(reg + (16 + 4 * g4 + qd) * KROW + (16 * c + 4 * pq) * 2));
          bf16x8 vf;
          vf[0] = lo[0]; vf[1] = lo[1]; vf[2] = lo[2]; vf[3] = lo[3];
          vf[4] = hi[0]; vf[5] = hi[1]; vf[6] = hi[2]; vf[7] = hi[3];
          o[c] = __builtin_amdgcn_mfma_f32_16x16x32_bf16(vf, pb, o[c], 0, 0, 0);
        }
      }
      lsum += __shfl_xor(lsum, 16);
      lsum += __shfl_xor(lsum, 32);
      const float inv = 1.f / lsum;
      if (hd < 8) {
#pragma unroll
        for (int c = 0; c < 8; ++c) {
          uint2 pk;
          pk.x = pack2(o[c][0] * inv, o[c][1] * inv);
          pk.y = pack2(o[c][2] * inv, o[c][3] * inv);
          *(uint2*)(ql + token * 1024 + hd * 128 + 16 * c + 4 * g4) = pk;
        }
      }
    }
  }
}

__device__ __forceinline__ void run_epilogue(const Params& p, int l, int epi, int b, int row0, int col0, int tid, const float* sC, int ncols) {
  char* ws = p.ws;
  switch (epi) {
    case 0: { EpiInProj e{(u16*)(ws + OFF_QB), (u16*)(ws + OFF_QI), (u16*)(ws + OFF_KI), (u16*)(ws + OFF_SGA), (u16*)(ws + OFF_SGS),
                          (u16*)(ws + OFF_UGM), (u16*)(ws + OFF_CN), (float*)(ws + OFF_WI), p.kvg + l * 128};
              e.run(b, row0, col0, tid, sC, ncols); } break;
    case 1: { EpiQlat e{(u16*)(ws + OFF_QL)}; e.run(b, row0, col0, tid, sC, ncols); } break;
    case 2: { EpiS e{(float*)(ws + OFF_S)}; e.run(b, row0, col0, tid, sC, ncols); } break;
    case 3: { EpiUv e{(const u16*)(ws + OFF_SGA), (u16*)(ws + OFF_XB)}; e.run(b, row0, col0, tid, sC, ncols); } break;
    case 4: { EpiY e{(const u16*)(ws + OFF_UGM), p.d_skip + l * 512, (u16*)(ws + OFF_QB)}; e.run(b, row0, col0, tid, sC, ncols); } break;
    case 5: { EpiGlu e{(const u16*)(ws + OFF_SGS), p.b_glu + l * 1024, (u16*)(ws + OFF_XB)}; e.run(b, row0, col0, tid, sC, ncols); } break;
    default: { EpiOut e{p.x, p.out, (const float*)(ws + OFF_STATS), p.ln_g + (l > 0 ? l - 1 : 0) * DM, p.ln_b + (l > 0 ? l - 1 : 0) * DM, l == 0 ? 1 : 0};
               e.run(b, row0, col0, tid, sC, ncols); } break;
  }
}

__device__ __forceinline__ void make_desc(GemmDesc& d, const Params& p, int l, int op) {
  char* ws = p.ws;
  d.A2 = nullptr; d.a2_bs = 0; d.lda2 = 0; d.ksplit = 1 << 30;
  switch (op) {
    case 0:
      d.A = (const u16*)(ws + OFF_XB); d.lda = DM; d.a_bs = 0;
      d.Bt = (const u16*)(ws + OFF_WINT) + (long)l * NPAD * DM; d.ldb = DM; d.b_bs = 0;
      d.M = NTOK; d.N = NPAD; d.K = DM; d.nbatch = 1; break;
    case 1:
      d.A = (const u16*)(ws + OFF_QB); d.lda = 512; d.a_bs = 64;
      d.Bt = (const u16*)(ws + OFF_WUK) + (long)l * 8 * 128 * 64; d.ldb = 64; d.b_bs = 128 * 64;
      d.M = NTOK; d.N = 128; d.K = 64; d.nbatch = 8; break;
    case 2:
      d.A = (const u16*)(ws + OFF_UGM); d.lda = 256; d.a_bs = (long)NTOK * 16;
      d.Bt = (const u16*)(ws + OFF_OP1) + (long)l * NGRP * 128 * 256; d.ldb = 256; d.b_bs = 128 * 256;
      d.M = NCHUNK; d.N = 128; d.K = 256; d.nbatch = NGRP; break;
    case 3:
      d.A = (const u16*)(ws + OFF_QL); d.lda = 1024; d.a_bs = 256;
      d.Bt = (const u16*)(ws + OFF_WUVP) + (long)l * 4 * 128 * 256; d.ldb = 256; d.b_bs = 128 * 256;
      d.M = NTOK; d.N = 128; d.K = 256; d.nbatch = 4; break;
    case 4:
      d.A = (const u16*)(ws + OFF_UGM); d.lda = 256; d.a_bs = (long)NTOK * 16;
      d.A2 = (const u16*)(ws + OFF_CKV); d.lda2 = 128; d.a2_bs = (long)NCHUNK * 128; d.ksplit = 256;
      d.Bt = (const u16*)(ws + OFF_OP2) + (long)l * NGRP * 256 * 384; d.ldb = 384; d.b_bs = 256 * 384;
      d.M = NCHUNK; d.N = 256; d.K = 384; d.nbatch = NGRP; break;
    case 5:
      d.A = (const u16*)(ws + OFF_QB); d.lda = 512; d.a_bs = 0;
      d.Bt = (const u16*)(ws + OFF_WGLUT) + (long)l * 1024 * 512; d.ldb = 512; d.b_bs = 0;
      d.M = NTOK; d.N = 1024; d.K = 512; d.nbatch = 1; break;
    default:
      d.A = (const u16*)(ws + OFF_XB); d.lda = DM; d.a_bs = 0;
      d.Bt = (const u16*)(ws + OFF_WOUTT) + (long)l * DM * DM; d.ldb = DM; d.b_bs = 0;
      d.M = NTOK; d.N = DM; d.K = DM; d.nbatch = 1; break;
  }
}

__device__ __forceinline__ void run_phase(const Params& p, int ph, int wid0, char* smem) {
  Ctx cx; cx.bid = blockIdx.x; cx.G = gridDim.x;
  {
    int wid_s = wid0; OPAQUE_S(wid_s);
    cx.tid = wid_s * 64 + (int)__builtin_amdgcn_mbcnt_hi(~0u, __builtin_amdgcn_mbcnt_lo(~0u, 0u));
  }
  OPAQUE_V(cx.tid); OPAQUE_S(cx.bid); OPAQUE_S(cx.G);
  if (ph == 0) { prologue_phase(cx, p, smem); return; }
  const int l = (ph - 1) / 7, s = (ph - 1) % 7;
  int op0 = -1, nops = 0;
  if (s == 0) { op0 = 0; nops = 1; }
  else if (s == 1) { op0 = 1; nops = 2; }
  else if (s == 3) { op0 = 3; nops = 2; }
  else if (s == 4) { op0 = 5; nops = 1; }
  else if (s == 5) { op0 = 6; nops = 1; }
  for (int i = 0; i < nops; ++i) {
    GemmDesc d;
    make_desc(d, p, l, op0 + i);
    gemm_phase(cx, d, op0 + i, p, l, smem);
  }

  if (s == 2) { scan_pass(cx, p, l); attn_phase(cx, p, smem); }
  if (s == 6) layernorm_pass(cx, p, l);
}

__global__ void __launch_bounds__(NTHR, 2) hymba_megakernel(Params p) {
  __shared__ __attribute__((aligned(16))) char smem[SMEM_BYTES];
  cg::grid_group grid = cg::this_grid();
  const int wid0 = __builtin_amdgcn_readfirstlane((int)(threadIdx.x >> 6));
  for (int ph = p.phase_lo; ph < p.phase_hi; ++ph) {
    run_phase(p, ph, wid0, smem);
    if (ph + 1 < p.phase_hi) grid.sync();
  }
}

#ifndef MULTI_LAUNCH
#define MULTI_LAUNCH 0
#endif

extern "C" void kernel_launch(void* const* d_in, const int* in_sizes, int n_in, void* d_out, int out_size, void* d_ws, size_t ws_size,
                              hipStream_t stream) {
  static int grid_blocks = 0;
  if (!grid_blocks) {
    int dev = 0, cus = 0, per_cu = 0;
    hipGetDevice(&dev);
    hipDeviceGetAttribute(&cus, hipDeviceAttributeMultiprocessorCount, dev);
    hipOccupancyMaxActiveBlocksPerMultiprocessor(&per_cu, hymba_megakernel, NTHR, 0);
    if (per_cu > 1) per_cu = 1;
    if (per_cu < 1) per_cu = 1;
    grid_blocks = cus * per_cu;
  }
  Params p{};
  p.x = (const float*)d_in[0]; p.w_in = (const float*)d_in[1]; p.kvg = (const float*)d_in[2]; p.w_uk = (const float*)d_in[3];
  p.w_uv = (const float*)d_in[4]; p.log_dt = (const float*)d_in[5]; p.a_re = (const float*)d_in[6]; p.a_im = (const float*)d_in[7];
  p.b_re = (const float*)d_in[8]; p.b_im = (const float*)d_in[9]; p.c_re = (const float*)d_in[10]; p.c_im = (const float*)d_in[11];
  p.d_skip = (const float*)d_in[12]; p.w_glu = (const float*)d_in[13]; p.b_glu = (const float*)d_in[14]; p.w_out = (const float*)d_in[15];
  p.ln_g = (const float*)d_in[16]; p.ln_b = (const float*)d_in[17];
  p.out = (float*)d_out; p.ws = (char*)d_ws;
  const int nph = 1 + 7 * DEPTH;
#if MULTI_LAUNCH
  for (int ph = 0; ph < nph; ++ph) {
    p.phase_lo = ph; p.phase_hi = ph + 1;
    hipLaunchKernelGGL(hymba_megakernel, dim3(grid_blocks), dim3(NTHR), 0, stream, p);
  }
#else
  p.phase_lo = 0; p.phase_hi = nph;
  void* args[] = {&p};
  hipError_t e = hipLaunchCooperativeKernel((void*)hymba_megakernel, dim3(grid_blocks), dim3(NTHR), args, 0, stream);
  if (e != hipSuccess) fprintf(stderr, "cooperative launch failed: %s (grid %d)\n", hipGetErrorString(e), grid_blocks);
#endif
}
```

```cpp
#include <hip/hip_runtime.h>
#include <hip/hip_bf16.h>
#include <hip/hip_cooperative_groups.h>
#include <cstdio>
namespace cg = cooperative_groups;

typedef __attribute__((ext_vector_type(8))) short bf16x8;
typedef __attribute__((ext_vector_type(4))) short s16x4;
typedef __attribute__((ext_vector_type(4))) float f32x4;
typedef __attribute__((ext_vector_type(16))) float f32x16;
typedef unsigned short u16;
typedef unsigned long long u64;

#define NTOK 65536
#define SEQL 4096
#define NBATCH 16
#define DM 1024
#define DIN 2472
#define NPAD 2560
#define DEPTH 4
#define NGRP 32
#define TCH 16
#define NCHUNK 4096
#define ALPHA 1.681792830507429f
#define SMEM_BYTES 151552
#define NTHR 512
#define NWV 8
#define REG_STRIDE 18944
#define KROW 272

#define MiB (1024ull * 1024ull)
#define OFF_XB    (0ull)
#define OFF_QB    (128 * MiB)
#define OFF_CKV   (192 * MiB)
#define OFF_CN    (224 * MiB)
#define OFF_QI    (240 * MiB)
#define OFF_KI    (272 * MiB)
#define OFF_WI    (276 * MiB)
#define OFF_SGA   (278 * MiB)
#define OFF_SGS   (342 * MiB)
#define OFF_UGM   (406 * MiB)
#define OFF_QL    (470 * MiB)
#define OFF_S     (598 * MiB)
#define OFF_STATS (662 * MiB)
#define OFF_WINT  (663 * MiB)
#define OFF_WOUTT (683 * MiB)
#define OFF_WGLUT (691 * MiB)
#define OFF_WUK   (695 * MiB)
#define OFF_WUVP  (696 * MiB)
#define OFF_OP1   (697 * MiB)
#define OFF_OP2   (705 * MiB)
#define OFF_AT    (729 * MiB)

struct Params {
  const float *x, *w_in, *kvg, *w_uk, *w_uv, *log_dt, *a_re, *a_im, *b_re, *b_im, *c_re, *c_im, *d_skip, *w_glu, *b_glu, *w_out, *ln_g, *ln_b;
  float* out;
  char* ws;
  int phase_lo, phase_hi;
};

struct Ctx { int tid, bid, G; };
#define OPAQUE_V(x) asm volatile("" : "+v"(x))
#define OPAQUE_S(x) asm volatile("" : "+s"(x))

__device__ __forceinline__ u16 f2bf(float f) {
  unsigned u = __float_as_uint(f);
  u += 0x7fffu + ((u >> 16) & 1u);
  return (u16)(u >> 16);
}
__device__ __forceinline__ float bf2f(u16 h) { return __uint_as_float(((unsigned)h) << 16); }
typedef __attribute__((ext_vector_type(2))) __bf16 bf16x2_t;
typedef __attribute__((ext_vector_type(2))) float f32x2_t;
__device__ __forceinline__ unsigned pack2(float a, float b) {
  f32x2_t v = {a, b};
  bf16x2_t r = __builtin_convertvector(v, bf16x2_t);
  return *(unsigned*)&r;
}
__device__ __forceinline__ float sigmoid_fast(float v) { return __builtin_amdgcn_rcpf(1.f + __builtin_amdgcn_exp2f(-1.4426950408889634f * v)); }
__device__ __forceinline__ float silu_f(float v) { return v * sigmoid_fast(v); }
__device__ __forceinline__ float gelu_tanh(float y) {
  float t = 0.7978845608028654f * (y + 0.044715f * y * y * y);
  return y * sigmoid_fast(2.f * t);
}

struct GemmDesc {
  const u16* A; const u16* A2; const u16* Bt;
  long a_bs, a2_bs, b_bs;
  int lda, lda2, ldb, ksplit;
  int M, N, K, nbatch;
};

#define LDT 72
#define CLD 132

__device__ __forceinline__ void run_epilogue(const Params& p, int l, int epi, int b, int row0, int col0, int tid, const float* sC, int ncols);

__device__ __forceinline__ void gemm_phase(const Ctx& cx, const GemmDesc& d, int epi, const Params& p, int l, char* smem) {
  const int tid = cx.tid, lane = tid & 63, wid = __builtin_amdgcn_readfirstlane(tid >> 6), wr = wid >> 2, wc = wid & 3;
  const int nM = d.M >> 8, nN = (d.N + 255) >> 8, nk = d.K >> 6;
  const int T = d.nbatch * nM * nN;
  const int G = cx.G, bid = cx.bid;
  int start, step, end;
  if ((G & 7) == 0) {
    int per = G >> 3, chunk = (T + 7) >> 3, xcd = bid & 7;
    start = xcd * chunk + (bid >> 3); step = per; end = min(T, (xcd + 1) * chunk);
  } else { start = bid; step = G; end = T; }
  const int lrow = lane >> 3;
  const int lsrc0 = ((lane & 7) ^ ((lane >> 4) & 7)) * 8;
  const int lsrc1 = ((lane & 7) ^ ((4 + (lane >> 4)) & 7)) * 8;
  const int fsw = (lane >> 1) & 7;
  const int ncols = min(256, d.N);
  const bool active = wc * 64 < ncols;
  bool prefetched = false;
  for (int t = start; t < end; t += step) {
#define TILE_DECODE(t_, m_, n_, b_, Ab_, A2b_, Bb_) do { \
      const int grp_ = (t_) / (4 * nN), rem_ = (t_) - grp_ * (4 * nN); \
      n_ = rem_ >> 2; const int r_ = grp_ * 4 + (rem_ & 3); m_ = r_ % nM; b_ = r_ / nM; \
      Ab_ = d.A + (long)b_ * d.a_bs + (long)(m_ * 256) * d.lda; \
      A2b_ = d.A2 ? d.A2 + (long)b_ * d.a2_bs + (long)(m_ * 256) * d.lda2 : nullptr; \
      Bb_ = d.Bt + (long)b_ * d.b_bs + (long)(n_ * 256) * d.ldb; \
    } while (0)
    int m, n, b; const u16 *Ab, *A2b, *Bb;
    TILE_DECODE(t, m, n, b, Ab, A2b, Bb);
    f32x4 acc[8][4];
#pragma unroll
    for (int i = 0; i < 8; ++i)
#pragma unroll
      for (int j = 0; j < 4; ++j) acc[i][j] = (f32x4){0.f, 0.f, 0.f, 0.f};
#define STAGE(kt_, s_) do { \
      const int k0_ = (kt_) * 64; \
      const u16* ap_; long ld_; \
      if (k0_ < d.ksplit) { ap_ = Ab + k0_; ld_ = d.lda; } else { ap_ = A2b + (k0_ - d.ksplit); ld_ = d.lda2; } \
      char* sa_ = smem + (s_) * 65536; \
      _Pragma("unroll") for (int j = 0; j < 4; ++j) { \
        const int g_ = wid * 4 + j;     \
        const int ls_ = (j & 1) ? lsrc1 : lsrc0; \
        __builtin_amdgcn_global_load_lds((const unsigned*)(ap_ + (long)(g_ * 8 + lrow) * ld_ + ls_), \
                                         (unsigned*)(sa_ + g_ * 1024 + lane * 16), 16, 0, 0); \
        const int br_ = (g_ * 8 + lrow) & (ncols - 1);     \
        __builtin_amdgcn_global_load_lds((const unsigned*)(Bb + (long)br_ * d.ldb + k0_ + ls_), \
                                         (unsigned*)(sa_ + 32768 + g_ * 1024 + lane * 16), 16, 0, 0); \
      } \
    } while (0)
    if (!prefetched) STAGE(0, 0);
    asm volatile("s_waitcnt vmcnt(0)" ::: "memory");
    __builtin_amdgcn_s_barrier();
    const int arow = (wr * 128 + (lane & 15)) * 128, brow = 32768 + (wc * 64 + (lane & 15)) * 128;
    for (int kt = 0; kt < nk; ++kt) {
      const int s = kt & 1;
      if (kt + 1 < nk) STAGE(kt + 1, s ^ 1);
      if (active) {
        const char* sb = smem + s * 65536;
#pragma unroll 1
        for (int kh = 0; kh < 2; ++kh) {
          bf16x8 fa[8], fb[4];
          const int co = (((4 * kh + (lane >> 4)) ^ fsw) * 16);
#pragma unroll
          for (int nt = 0; nt < 4; ++nt) fb[nt] = *(const bf16x8*)(sb + brow + nt * 16 * 128 + co);
          fa[0] = *(const bf16x8*)(sb + arow + co);
          fa[1] = *(const bf16x8*)(sb + arow + 16 * 128 + co);
          __builtin_amdgcn_sched_barrier(0);
          acc[0][0] = __builtin_amdgcn_mfma_f32_16x16x32_bf16(fb[0], fa[0], acc[0][0], 0, 0, 0);
          __builtin_amdgcn_sched_barrier(0);
#pragma unroll
          for (int mt = 2; mt < 8; ++mt) fa[mt] = *(const bf16x8*)(sb + arow + mt * 16 * 128 + co);
          __builtin_amdgcn_sched_barrier(0);
#pragma unroll
          for (int nt = 1; nt < 4; ++nt)
            acc[0][nt] = __builtin_amdgcn_mfma_f32_16x16x32_bf16(fb[nt], fa[0], acc[0][nt], 0, 0, 0);
#pragma unroll
          for (int nt = 0; nt < 4; ++nt)
            acc[1][nt] = __builtin_amdgcn_mfma_f32_16x16x32_bf16(fb[nt], fa[1], acc[1][nt], 0, 0, 0);
          __builtin_amdgcn_sched_barrier(0);
#pragma unroll
          for (int mt = 2; mt < 8; ++mt)
#pragma unroll
            for (int nt = 0; nt < 4; ++nt)
              acc[mt][nt] = __builtin_amdgcn_mfma_f32_16x16x32_bf16(fb[nt], fa[mt], acc[mt][nt], 0, 0, 0);
          __builtin_amdgcn_sched_barrier(0);
        }
      }
      asm volatile("s_waitcnt vmcnt(0)" ::: "memory");
      __builtin_amdgcn_s_barrier();
    }
    const int m_cur = m, n_cur = n, b_cur = b;
    prefetched = false;
    if (t + step < end && (nk & 1) == 0) {
      TILE_DECODE(t + step, m, n, b, Ab, A2b, Bb);
      STAGE(0, 0);
      prefetched = true;
    }
    float* sC = (float*)(smem + 65536);
#pragma unroll
    for (int q = 0; q < 2; ++q)
#pragma unroll
      for (int ch = 0; ch < 2; ++ch) {
        if (ch * 128 < ncols) {
          if (q | ch) __syncthreads();
          if (active && (wc >> 1) == ch) {
#pragma unroll
            for (int mt2 = 0; mt2 < 4; ++mt2)
#pragma unroll
              for (int nt = 0; nt < 4; ++nt)
                *(f32x4*)(sC + (wr * 64 + mt2 * 16 + (lane & 15)) * CLD + (wc & 1) * 64 + nt * 16 + 4 * (lane >> 4)) = acc[4 * q + mt2][nt];
          }
          __syncthreads();
          run_epilogue(p, l, epi, b_cur, m_cur * 256 + q * 64, n_cur * 256 + ch * 128, tid, sC, 128);
        }
      }
  }
}

__device__ __forceinline__ uint2 pack4(float4 v) {
  uint2 pk;
  pk.x = pack2(v.x, v.y);
  pk.y = pack2(v.z, v.w);
  return pk;
}
__device__ __forceinline__ float4 unpack4(uint2 u) {
  float4 v;
  v.x = __uint_as_float(u.x << 16); v.y = __uint_as_float(u.x & 0xffff0000u);
  v.z = __uint_as_float(u.y << 16); v.w = __uint_as_float(u.y & 0xffff0000u);
  return v;
}
template <class F>
__device__ __forceinline__ void epi_each(int row0, int col0, int tid, const float* sC, int ncols, const F& f) {
#pragma unroll 2
  for (int j = 0; j < 8; ++j) {
    const int e = tid + NTHR * j;
    const int r = e >> 5, c = (e & 31) * 4;
    const float4 v = *(const float4*)(sC + r * CLD + c);
    f(row0 + r + (r & 64), col0 + c, v);
  }
}

struct EpiInProj {
  u16 *qb, *qi, *ki, *sga, *sgs, *ugm, *cn; float *wi; const float* kvg;
  __device__ __forceinline__ void run(int b, int row0, int col0, int tid, const float* sC, int ncols) const {
    const EpiInProj& s = *this;
    if (col0 == 512) {
      const int lane = tid & 63;
      const float4 gv = *(const float4*)(s.kvg + (lane & 31) * 4);
#pragma unroll 2
      for (int j = 0; j < 8; ++j) {
        const int e = tid + NTHR * j;
        const int r = e >> 5, c = (e & 31) * 4;
        const float4 v = *(const float4*)(sC + r * CLD + c);
        const long row = row0 + r + (r & 64);
        float ss = v.x * v.x + v.y * v.y + v.z * v.z + v.w * v.w;
        ss += __shfl_xor(ss, 16); ss += __shfl_xor(ss, 8); ss += __shfl_xor(ss, 4); ss += __shfl_xor(ss, 2); ss += __shfl_xor(ss, 1);
        const float rs = rsqrtf(ss * (1.f / 128.f) + 1e-6f);
        float4 w; w.x = v.x * rs * gv.x; w.y = v.y * rs * gv.y; w.z = v.z * rs * gv.z; w.w = v.w * rs * gv.w;
        *(uint2*)(s.cn + row * 128 + c) = pack4(w);
      }
      return;
    }
    epi_each(row0, col0, tid, sC, ncols, [&](int row, int col, float4 v) {
      if (col < 512) *(uint2*)(s.qb + (long)row * 512 + col) = pack4(v);
      else if (col < 896) *(uint2*)(s.qi + (long)row * 256 + (col - 640)) = pack4(v);
      else if (col < 928) *(uint2*)(s.ki + (long)row * 32 + (col - 896)) = pack4(v);
      else if (col < 936) { float4 w = v; w.x *= 0.0625f; w.y *= 0.0625f; w.z *= 0.0625f; w.w *= 0.0625f; *(float4*)(s.wi + (long)row * 8 + (col - 928)) = w; }
      else if (col < 1024) {}
      else if (col < 1536) { float4 w; w.x = silu_f(v.x); w.y = silu_f(v.y); w.z = silu_f(v.z); w.w = silu_f(v.w); *(uint2*)(s.sga + (long)row * 512 + (col - 1024)) = pack4(w); }
      else if (col < 2048) { int cc = col - 1536; *(uint2*)(s.ugm + ((long)(cc >> 4) * NTOK + row) * 16 + (cc & 15)) = pack4(v); }
      else { float4 w; w.x = silu_f(v.x); w.y = silu_f(v.y); w.z = silu_f(v.z); w.w = silu_f(v.w); *(uint2*)(s.sgs + (long)row * 512 + (col - 2048)) = pack4(w); }
    });
  }
};
struct EpiQlat {
  u16* ql;
  __device__ __forceinline__ void run(int b, int row0, int col0, int tid, const float* sC, int ncols) const {
    u16* o = ql;
    epi_each(row0, col0, tid, sC, ncols, [&](int row, int col, float4 v) { *(uint2*)(o + (long)row * 1024 + b * 128 + col) = pack4(v); });
  }
};
struct EpiS {
  float* S;
  __device__ __forceinline__ void run(int b, int row0, int col0, int tid, const float* sC, int ncols) const {
    float* o = S;
    epi_each(row0, col0, tid, sC, ncols, [&](int row, int col, float4 v) { *(float4*)(o + ((long)b * NCHUNK + row) * 128 + col) = v; });
  }
};
struct EpiUv {
  const u16* sga; u16* mixed;
  __device__ __forceinline__ void run(int b, int row0, int col0, int tid, const float* sC, int ncols) const {
    const u16* g = sga; u16* o = mixed;
    epi_each(row0, col0, tid, sC, ncols, [&](int row, int col, float4 v) {
      int c2 = b * 128 + col;
      float4 gv = unpack4(*(const uint2*)(g + (long)row * 512 + c2));
      float4 w; w.x = v.x * gv.x; w.y = v.y * gv.y; w.z = v.z * gv.z; w.w = v.w * gv.w;
      *(uint2*)(o + (long)row * 1024 + c2) = pack4(w);
    });
  }
};
struct EpiY {
  const u16* ugm; const float* dsk; u16* yact;
  __device__ __forceinline__ void run(int b, int row0, int col0, int tid, const float* sC, int ncols) const {
    const u16* u = ugm; const float* dd = dsk; u16* o = yact;
    epi_each(row0, col0, tid, sC, ncols, [&](int row, int col, float4 v) {
      int t = col >> 4, c = col & 15;
      long token = (long)row * TCH + t;
      float4 uv = unpack4(*(const uint2*)(u + ((long)b * NTOK + token) * 16 + c));
      float4 dv = *(const float4*)(dd + b * 16 + c);
      float4 w;
      w.x = gelu_tanh(v.x + dv.x * uv.x); w.y = gelu_tanh(v.y + dv.y * uv.y);
      w.z = gelu_tanh(v.z + dv.z * uv.z); w.w = gelu_tanh(v.w + dv.w * uv.w);
      *(uint2*)(o + token * 512 + b * 16 + c) = pack4(w);
    });
  }
};
struct EpiGlu {
  const u16* sgs; const float* bglu; u16* mixed;
  __device__ __forceinline__ void run(int b, int row0, int col0, int tid, const float* sC, int ncols) const {
#pragma unroll 2
    for (int jj = 0; jj < 4; ++jj) {
      const int e = tid + NTHR * jj;
      const int r = e >> 4, q = e & 15, gi = q >> 3, qq = q & 7;
      const float4 va = *(const float4*)(sC + r * CLD + gi * 64 + qq * 4);
      const float4 ga = *(const float4*)(sC + r * CLD + gi * 64 + 32 + qq * 4);
      const int j = (col0 >> 1) + gi * 32 + qq * 4;
      const long row = row0 + r + (r & 64);
      const float4 bv = *(const float4*)(bglu + j), bg = *(const float4*)(bglu + 512 + j);
      const float4 sg = unpack4(*(const uint2*)(sgs + row * 512 + j));
      float4 w;
      w.x = (va.x + bv.x) * sigmoid_fast(ga.x + bg.x) * sg.x;
      w.y = (va.y + bv.y) * sigmoid_fast(ga.y + bg.y) * sg.y;
      w.z = (va.z + bv.z) * sigmoid_fast(ga.z + bg.z) * sg.z;
      w.w = (va.w + bv.w) * sigmoid_fast(ga.w + bg.w) * sg.w;
      *(uint2*)(mixed + row * 1024 + 512 + j) = pack4(w);
    }
  }
};
struct EpiOut {
  const float* xin; float* z; const float* stats; const float* g; const float* bb; int first;
  __device__ __forceinline__ void run(int b, int row0, int col0, int tid, const float* sC, int ncols) const {
    const EpiOut& s = *this;
    epi_each(row0, col0, tid, sC, ncols, [&](int row, int col, float4 v) {
      long idx = (long)row * 1024 + col;
      float4 xp;
      if (s.first) xp = *(const float4*)(s.xin + idx);
      else {
        float mu = s.stats[2 * row], rs = s.stats[2 * row + 1];
        float4 zo = *(const float4*)(s.z + idx), gv = *(const float4*)(s.g + col), bv = *(const float4*)(s.bb + col);
        xp.x = (zo.x - mu) * rs * gv.x + bv.x; xp.y = (zo.y - mu) * rs * gv.y + bv.y;
        xp.z = (zo.z - mu) * rs * gv.z + bv.z; xp.w = (zo.w - mu) * rs * gv.w + bv.w;
      }
      float4 o; o.x = ALPHA * xp.x + v.x; o.y = ALPHA * xp.y + v.y; o.z = ALPHA * xp.z + v.z; o.w = ALPHA * xp.w + v.w;
      *(float4*)(s.z + idx) = o;
    });
  }
};

template <class CM>
__device__ __forceinline__ void transpose_tile(const Ctx& cx, const float* src, int sld, u16* dst, int dld, int k0, int n0, const CM& colmap, char* smem) {
  float* tile = (float*)smem;
  const int tid = cx.tid;
  __syncthreads();
  for (int e = tid; e < 4096; e += NTHR) {
    int kk = e >> 6, nn = e & 63;
    int sc = colmap(n0 + nn);
    tile[kk * 65 + nn] = sc >= 0 ? src[(long)(k0 + kk) * sld + sc] : 0.f;
  }
  __syncthreads();
  for (int e = tid; e < 4096; e += NTHR) {
    int nn = e >> 6, kk = e & 63;
    dst[(long)(n0 + nn) * dld + k0 + kk] = f2bf(tile[kk * 65 + nn]);
  }
}

__device__ __forceinline__ void ssm_ops(const Ctx& cx, const Params& p, int l, int g, char* smem) {
  float* ap = (float*)smem;
  float* bbm = ap + 17 * 64 * 2;
  float* ccm = bbm + 64 * 16 * 2;
  float* kj = ccm + 16 * 64 * 2;
  const int tid = cx.tid;
  const int lg = l * NGRP + g;
  __syncthreads();
  if (tid < 64) {
    const int pp = tid;
    float dt = expf(p.log_dt[lg]);
    float lr = p.a_re[lg * 64 + pp], li = p.a_im[lg * 64 + pp];
    for (int j = 0; j <= 16; ++j) {
      float mag = expf(lr * dt * (float)j);
      float sn, cs; sincosf(li * dt * (float)j, &sn, &cs);
      ap[(j * 64 + pp) * 2] = mag * cs; ap[(j * 64 + pp) * 2 + 1] = mag * sn;
    }
    float ar = ap[(1 * 64 + pp) * 2], ai = ap[(1 * 64 + pp) * 2 + 1];
    float den = lr * lr + li * li;
    float cr = ((ar - 1.f) * lr + ai * li) / den;
    float ci = (ai * lr - (ar - 1.f) * li) / den;
    for (int c = 0; c < 16; ++c) {
      float br = p.b_re[((long)lg * 64 + pp) * 16 + c], bi = p.b_im[((long)lg * 64 + pp) * 16 + c];
      bbm[(pp * 16 + c) * 2] = cr * br - ci * bi;
      bbm[(pp * 16 + c) * 2 + 1] = cr * bi + ci * br;
    }
    float* at = (float*)(p.ws + OFF_AT) + ((long)lg * 64 + pp) * 2;
    at[0] = ap[(16 * 64 + pp) * 2]; at[1] = ap[(16 * 64 + pp) * 2 + 1];
  }
  for (int e = tid; e < 1024; e += NTHR) {
    ccm[e * 2] = p.c_re[(long)lg * 1024 + e];
    ccm[e * 2 + 1] = p.c_im[(long)lg * 1024 + e];
  }
  __syncthreads();
  for (int e = tid; e < 4096; e += NTHR) {
    int j = e >> 8, cp = (e >> 4) & 15, c = e & 15;
    float s = 0.f;
    for (int pp = 0; pp < 64; ++pp) {
      float c_r = ccm[(cp * 64 + pp) * 2], c_i = ccm[(cp * 64 + pp) * 2 + 1];
      float a_r = ap[(j * 64 + pp) * 2], a_i = ap[(j * 64 + pp) * 2 + 1];
      float er = c_r * a_r - c_i * a_i, ei = c_r * a_i + c_i * a_r;
      s += er * bbm[(pp * 16 + c) * 2] - ei * bbm[(pp * 16 + c) * 2 + 1];
    }
    kj[e] = s;
  }
  __syncthreads();
  u16* op2 = (u16*)(p.ws + OFF_OP2) + (long)lg * 256 * 384;
  for (int e = tid; e < 256 * 384; e += NTHR) {
    int n = e / 384, k = e - n * 384;
    int t = n >> 4, cp = n & 15;
    float v;
    if (k < 256) {
      int s = k >> 4, c = k & 15;
      v = (s <= t) ? kj[((t - s) * 16 + cp) * 16 + c] : 0.f;
    } else {
      int j = k - 256, pp = j & 63;
      float c_r = ccm[(cp * 64 + pp) * 2], c_i = ccm[(cp * 64 + pp) * 2 + 1];
      float a_r = ap[((t + 1) * 64 + pp) * 2], a_i = ap[((t + 1) * 64 + pp) * 2 + 1];
      v = (j < 64) ? (c_r * a_r - c_i * a_i) : -(c_r * a_i + c_i * a_r);
    }
    op2[e] = f2bf(v);
  }
  u16* op1 = (u16*)(p.ws + OFF_OP1) + (long)lg * 128 * 256;
  for (int e = tid; e < 128 * 256; e += NTHR) {
    int j = e >> 8, k = e & 255;
    int pp = j & 63, s = k >> 4, c = k & 15;
    float a_r = ap[((15 - s) * 64 + pp) * 2], a_i = ap[((15 - s) * 64 + pp) * 2 + 1];
    float b_r = bbm[(pp * 16 + c) * 2], b_i = bbm[(pp * 16 + c) * 2 + 1];
    float v = (j < 64) ? (a_r * b_r - a_i * b_i) : (a_r * b_i + a_i * b_r);
    op1[e] = f2bf(v);
  }
}

__device__ __forceinline__ void prologue_phase(const Ctx& cx, const Params& p, char* smem) {
  const int G = cx.G, bid = cx.bid, tid = cx.tid;
  for (int it = bid; it < DEPTH * NGRP; it += G) ssm_ops(cx, p, it / NGRP, it % NGRP, smem);
  for (int it = bid; it < DEPTH * 16 * 40; it += G) {
    int l = it / 640, r = it % 640, kt = r / 40, ntile = r % 40;
    transpose_tile(cx, p.w_in + (long)l * DM * DIN, DIN, (u16*)(p.ws + OFF_WINT) + (long)l * NPAD * DM, DM, kt * 64, ntile * 64,
                   [](int n) { return n < 936 ? n : (n < 1024 ? -1 : n - 88); }, smem);
  }
  for (int it = bid; it < DEPTH * 256; it += G) {
    int l = it >> 8, r = it & 255, kt = r >> 4, ntile = r & 15;
    transpose_tile(cx, p.w_out + (long)l * DM * DM, DM, (u16*)(p.ws + OFF_WOUTT) + (long)l * DM * DM, DM, kt * 64, ntile * 64,
                   [](int n) { return n; }, smem);
  }
  for (int it = bid; it < DEPTH * 128; it += G) {
    int l = it >> 7, r = it & 127, kt = r >> 4, ntile = r & 15;
    transpose_tile(cx, p.w_glu + (long)l * 512 * 1024, 1024, (u16*)(p.ws + OFF_WGLUT) + (long)l * 1024 * 512, 512, kt * 64, ntile * 64,
                   [](int n) { return ((n >> 5) & 1) * 512 + (n >> 6) * 32 + (n & 31); }, smem);
  }
  const long gtid = (long)bid * NTHR + tid, gsz = (long)G * NTHR;
  {
    u16* o = (u16*)(p.ws + OFF_WUK);
    for (long e = gtid; e < (long)DEPTH * 8 * 128 * 64; e += gsz) o[e] = f2bf(0.125f * 1.4426950408889634f * p.w_uk[e]);
  }
  {
    u16* o = (u16*)(p.ws + OFF_WUVP);
    for (long e = gtid; e < (long)DEPTH * 4 * 128 * 256; e += gsz) {
      int k = e & 255, n = (e >> 8) & 127, j = (e >> 15) & 3, l = (int)(e >> 17);
      int hh = n >> 6, dd = n & 63, hh2 = k >> 7, c = k & 127;
      float v = (hh == hh2) ? p.w_uv[(((long)l * 8 + 2 * j + hh) * 128 + c) * 64 + dd] : 0.f;
      o[e] = f2bf(v);
    }
  }
  {
    u16* o = (u16*)(p.ws + OFF_XB);
    const float4* xi = (const float4*)p.x;
    for (long e = gtid; e < (long)NTOK * DM / 4; e += gsz) {
      float4 v = xi[e];
      uint2 pk;
      pk.x = pack2(v.x, v.y);
      pk.y = pack2(v.z, v.w);
      *(uint2*)(o + e * 4) = pk;
    }
  }
}

__device__ __forceinline__ void rmsnorm_pass(const Ctx& cx, const Params& p, int l) {
  const float* ckv = (const float*)(p.ws + OFF_CKV);
  u16* cn = (u16*)(p.ws + OFF_CN);
  const float* g = p.kvg + l * 128;
  const int lane = cx.tid & 63, half = lane >> 5, l32 = lane & 31;
  const long gw = (long)cx.bid * NWV + (cx.tid >> 6), nw = (long)cx.G * NWV;
  const float4 gv = *(const float4*)(g + l32 * 4);
  for (long it = gw; it < NTOK / 2; it += nw) {
    long tok = it * 2 + half;
    float4 v = *(const float4*)(ckv + tok * 128 + l32 * 4);
    float ss = v.x * v.x + v.y * v.y + v.z * v.z + v.w * v.w;
    ss += __shfl_xor(ss, 16); ss += __shfl_xor(ss, 8); ss += __shfl_xor(ss, 4); ss += __shfl_xor(ss, 2); ss += __shfl_xor(ss, 1);
    float rs = rsqrtf(ss * (1.f / 128.f) + 1e-6f);
    uint2 pk;
    pk.x = pack2(v.x * rs * gv.x, v.y * rs * gv.y);
    pk.y = pack2(v.z * rs * gv.z, v.w * rs * gv.w);
    *(uint2*)(cn + tok * 128 + l32 * 4) = pk;
  }
}

__device__ __forceinline__ void layernorm_pass(const Ctx& cx, const Params& p, int l) {
  float* z = p.out;
  float* stats = (float*)(p.ws + OFF_STATS);
  u16* xb = (u16*)(p.ws + OFF_XB);
  const float* g = p.ln_g + l * DM; const float* bb = p.ln_b + l * DM;
  const int lane = cx.tid & 63;
  const long gw = (long)cx.bid * NWV + (cx.tid >> 6), nw = (long)cx.G * NWV;
  float4 gv[4], bv[4];
#pragma unroll
  for (int j = 0; j < 4; ++j) { gv[j] = *(const float4*)(g + j * 256 + lane * 4); bv[j] = *(const float4*)(bb + j * 256 + lane * 4); }
  for (long row = gw; row < NTOK; row += nw) {
    float4 v[4];
    float s = 0.f;
#pragma unroll
    for (int j = 0; j < 4; ++j) { v[j] = *(const float4*)(z + row * DM + j * 256 + lane * 4); s += v[j].x + v[j].y + v[j].z + v[j].w; }
#pragma unroll
    for (int o = 32; o >= 1; o >>= 1) s += __shfl_xor(s, o);
    float mu = s * (1.f / 1024.f);
    float q = 0.f;
#pragma unroll
    for (int j = 0; j < 4; ++j) {
      float a = v[j].x - mu, b = v[j].y - mu, c = v[j].z - mu, d = v[j].w - mu;
      q += a * a + b * b + c * c + d * d;
    }
#pragma unroll
    for (int o = 32; o >= 1; o >>= 1) q += __shfl_xor(q, o);
    float rs = rsqrtf(q * (1.f / 1024.f) + 1e-5f);
    if (l == DEPTH - 1) {
#pragma unroll
      for (int j = 0; j < 4; ++j) {
        float4 o;
        o.x = (v[j].x - mu) * rs * gv[j].x + bv[j].x; o.y = (v[j].y - mu) * rs * gv[j].y + bv[j].y;
        o.z = (v[j].z - mu) * rs * gv[j].z + bv[j].z; o.w = (v[j].w - mu) * rs * gv[j].w + bv[j].w;
        *(float4*)(z + row * DM + j * 256 + lane * 4) = o;
      }
    } else {
      if (lane == 0) { stats[2 * row] = mu; stats[2 * row + 1] = rs; }
#pragma unroll
      for (int j = 0; j < 4; ++j) {
        float a = (v[j].x - mu) * rs * gv[j].x + bv[j].x, b = (v[j].y - mu) * rs * gv[j].y + bv[j].y;
        float c = (v[j].z - mu) * rs * gv[j].z + bv[j].z, d = (v[j].w - mu) * rs * gv[j].w + bv[j].w;
        uint2 pk;
        pk.x = pack2(a, b);
        pk.y = pack2(c, d);
        *(uint2*)(xb + row * DM + j * 256 + lane * 4) = pk;
      }
    }
  }
}

__device__ __forceinline__ void scan_pass(const Ctx& cx, const Params& p, int l) {
  const float* S = (const float*)(p.ws + OFF_S);
  u16* Xin = (u16*)(p.ws + OFF_CKV);
  const int lane = cx.tid & 63;
  const int gw = cx.bid * NWV + (cx.tid >> 6), nw = cx.G * NWV;
  for (int it = gw; it < NBATCH * NGRP; it += nw) {
    int b = it >> 5, g = it & 31;
    const float* at = (const float*)(p.ws + OFF_AT) + ((long)(l * NGRP + g) * 64 + lane) * 2;
    const float ar = at[0], ai = at[1];
    float xr = 0.f, xi = 0.f;
    long row0 = (long)g * NCHUNK + b * 256;
    for (int k0 = 0; k0 < 256; k0 += 32) {
      float sr[32], si[32];
#pragma unroll
      for (int j = 0; j < 32; ++j) { sr[j] = S[(row0 + k0 + j) * 128 + lane]; si[j] = S[(row0 + k0 + j) * 128 + 64 + lane]; }
#pragma unroll
      for (int j = 0; j < 32; ++j) {
        Xin[(row0 + k0 + j) * 128 + lane] = f2bf(xr);
        Xin[(row0 + k0 + j) * 128 + 64 + lane] = f2bf(xi);
        float nr = ar * xr - ai * xi + sr[j];
        float ni = ar * xi + ai * xr + si[j];
        xr = nr; xi = ni;
      }
    }
  }
}

__device__ __forceinline__ unsigned sortable(float f) {
  unsigned u = __float_as_uint(f);
  return u ^ ((unsigned)((int)u >> 31) | 0x80000000u);
}
__device__ __forceinline__ int mbcnt64(u64 m) {
  return __builtin_amdgcn_mbcnt_hi((unsigned)(m >> 32), __builtin_amdgcn_mbcnt_lo((unsigned)m, 0));
}

__device__ __forceinline__ void attn_phase(const Ctx& cx, const Params& p, char* smem) {
  const u16* qi = (const u16*)(p.ws + OFF_QI);
  const u16* ki = (const u16*)(p.ws + OFF_KI);
  const float* wi = (const float*)(p.ws + OFF_WI);
  const u16* cn = (const u16*)(p.ws + OFF_CN);
  u16* ql = (u16*)(p.ws + OFF_QL);
  const int tid = cx.tid, lane = tid & 63, wid = __builtin_amdgcn_readfirstlane(tid >> 6);
  const int hh = lane >> 5;
  const int G = cx.G;
  for (int item = cx.bid; item < (SEQL / 8) * NBATCH; item += G) {
    const int tq = (SEQL / 8 - 1) - (item >> 4), b = item & 15;
    const int t0 = tq * 8;
    const long tokbase = (long)b * SEQL;
    {
      const int r = lane & 31;
      const int qq = 2 * ((r >> 2) & 1) + (r >> 4), head = (r & 3) + 4 * ((r >> 3) & 1);
      const u16* qip = qi + (tokbase + t0 + qq) * 256 + head * 32 + 8 * hh;
      const bf16x8 qa0 = *(const bf16x8*)qip, qa1 = *(const bf16x8*)(qip + 16);
      const bf16x8 qb0 = *(const bf16x8*)(qip + 4 * 256), qb1 = *(const bf16x8*)(qip + 4 * 256 + 16);
      float w0[8], w1[8], w2[8], w3[8];
      {
        const float4* wp = (const float4*)(wi + (tokbase + t0 + 2 * hh) * 8);
        float4 a = wp[0], bq = wp[1], c = wp[2], d = wp[3];
        w0[0] = a.x; w0[1] = a.y; w0[2] = a.z; w0[3] = a.w; w0[4] = bq.x; w0[5] = bq.y; w0[6] = bq.z; w0[7] = bq.w;
        w1[0] = c.x; w1[1] = c.y; w1[2] = c.z; w1[3] = c.w; w1[4] = d.x; w1[5] = d.y; w1[6] = d.z; w1[7] = d.w;
        const float4* wq = (const float4*)(wi + (tokbase + t0 + 4 + 2 * hh) * 8);
        a = wq[0]; bq = wq[1]; c = wq[2]; d = wq[3];
        w2[0] = a.x; w2[1] = a.y; w2[2] = a.z; w2[3] = a.w; w2[4] = bq.x; w2[5] = bq.y; w2[6] = bq.z; w2[7] = bq.w;
        w3[0] = c.x; w3[1] = c.y; w3[2] = c.z; w3[3] = c.w; w3[4] = d.x; w3[5] = d.y; w3[6] = d.z; w3[7] = d.w;
      }
      const int ntiles = ((t0 + 7) >> 5) + 1;
      const int q0 = t0 + 2 * hh;
      unsigned* sc0 = (unsigned*)(smem + (2 * hh) * REG_STRIDE);
      unsigned* sc1 = (unsigned*)(smem + (2 * hh + 1) * REG_STRIDE);
      unsigned* sc2 = (unsigned*)(smem + (4 + 2 * hh) * REG_STRIDE);
      unsigned* sc3 = (unsigned*)(smem + (4 + 2 * hh + 1) * REG_STRIDE);
      __syncthreads();
      bf16x8 nk0, nk1;
      {
        const u16* kp = ki + (tokbase + min(wid, ntiles - 1) * 32 + r) * 32 + 8 * hh;
        nk0 = *(const bf16x8*)kp; nk1 = *(const bf16x8*)(kp + 16);
      }
      for (int tile = wid; tile < ntiles; tile += NWV) {
        const int key = tile * 32 + r;
        const bf16x8 kb0 = nk0, kb1 = nk1;
        {
          const u16* kp = ki + (tokbase + min(tile + NWV, ntiles - 1) * 32 + r) * 32 + 8 * hh;
          nk0 = *(const bf16x8*)kp; nk1 = *(const bf16x8*)(kp + 16);
        }
        f32x16 acc, acd;
#pragma unroll
        for (int e = 0; e < 16; ++e) { acc[e] = 0.f; acd[e] = 0.f; }
        acc = __builtin_amdgcn_mfma_f32_32x32x16_bf16(qa0, kb0, acc, 0, 0, 0);
        acd = __builtin_amdgcn_mfma_f32_32x32x16_bf16(qb0, kb0, acd, 0, 0, 0);
        acc = __builtin_amdgcn_mfma_f32_32x32x16_bf16(qa1, kb1, acc, 0, 0, 0);
        acd = __builtin_amdgcn_mfma_f32_32x32x16_bf16(qb1, kb1, acd, 0, 0, 0);
        float s0 = 0.f, s1 = 0.f, s2 = 0.f, s3 = 0.f;
#pragma unroll
        for (int e = 0; e < 8; ++e) {
          s0 += w0[e] * fmaxf(acc[e], 0.f); s1 += w1[e] * fmaxf(acc[8 + e], 0.f);
          s2 += w2[e] * fmaxf(acd[e], 0.f); s3 += w3[e] * fmaxf(acd[8 + e], 0.f);
        }
        sc0[key] = (key <= q0) ? sortable(s0) : 0u;
        sc1[key] = (key <= q0 + 1) ? sortable(s1) : 0u;
        sc2[key] = (key <= q0 + 4) ? sortable(s2) : 0u;
        sc3[key] = (key <= q0 + 5) ? sortable(s3) : 0u;
      }
      __syncthreads();
    }
    const int t = t0 + wid;
    char* reg = smem + wid * REG_STRIDE;
    const unsigned* sc = (const unsigned*)reg;
    u16* sel = (u16*)(reg + 18432);
    const int nvalid = t + 1;
    int count;
    if (nvalid <= 256) {
      count = nvalid;
      for (int i = lane; i < 256; i += 64) sel[i] = (u16)(i < nvalid ? i : 0);
    } else {
      count = 256;
      unsigned v[64];
#pragma unroll
      for (int i = 0; i < 64; ++i) { int key = i * 64 + lane; v[i] = (key < nvalid) ? sc[key] : 0u; }
      const int ni = (nvalid + 63) >> 6;
#define CNT_GE(THR, CNT) do { \
        int c_ = 0; \
        _Pragma("unroll") for (int gq = 0; gq < 4; ++gq) { \
          if (gq * 16 < ni) { \
            _Pragma("unroll") for (int j = 0; j < 16; ++j) c_ += __builtin_popcountll(__ballot(v[gq * 16 + j] >= (THR))); \
          } \
        } \
        CNT = c_; } while (0)
      unsigned vmax = 0u;
#pragma unroll
      for (int i = 0; i < 64; ++i) vmax = max(vmax, v[i]);
#pragma unroll
      for (int o = 32; o >= 1; o >>= 1) vmax = max(vmax, (unsigned)__shfl_xor((int)vmax, o));
      vmax = (unsigned)__builtin_amdgcn_readfirstlane((int)vmax);
      unsigned lo = 0u, hi = vmax + 1u;
      int clo = 4096, chi = 0;
      bool positive = false;
      {
        int c0; CNT_GE(0x80000000u, c0);
        if (c0 >= 256) { lo = 0x80000000u; clo = c0; positive = true; }
        else { hi = 0x80000000u; chi = c0; }
      }
      while (clo != 256 && clo - chi > 128 && hi - lo > 1u) {
        unsigned mid = lo + ((hi - lo) >> 1);
        if (positive) {
          const float fm = 0.5f * (__uint_as_float(lo & 0x7fffffffu) + __uint_as_float(hi & 0x7fffffffu));
          const unsigned m2 = __float_as_uint(fm) | 0x80000000u;
          if (m2 > lo && m2 < hi) mid = m2;
        }
        int cnt; CNT_GE(mid, cnt);
        if (cnt >= 256) { lo = mid; clo = cnt; } else { hi = mid; chi = cnt; }
      }
      if (clo <= 384) {
        unsigned* dval = (unsigned*)(reg + 8192);
        u16* dkey = (u16*)(reg + 8192 + 1536);
        {
          int base = 0;
#pragma unroll
          for (int gq = 0; gq < 4; ++gq) {
            if (gq * 16 < ni) {
#pragma unroll
              for (int j = 0; j < 16; ++j) {
                const int i = gq * 16 + j;
                const bool in = v[i] >= lo;
                const u64 m = __ballot(in);
                if (in) { const int pos = base + mbcnt64(m); dval[pos] = v[i]; dkey[pos] = (u16)(i * 64 + lane); }
                base += __builtin_popcountll(m);
              }
            }
          }
        }
        unsigned dv[6]; int dk[6];
#pragma unroll
        for (int j = 0; j < 6; ++j) {
          const int idx = j * 64 + lane;
          dv[j] = (idx < clo) ? dval[idx] : 0u;
          dk[j] = (idx < clo) ? (int)dkey[idx] : 0;
        }
        while (clo != 256 && hi - lo > 1u) {
          const unsigned mid = lo + ((hi - lo) >> 1);
          int cnt = 0;
#pragma unroll
          for (int j = 0; j < 6; ++j) cnt += __builtin_popcountll(__ballot(dv[j] >= mid));
          if (cnt >= 256) { lo = mid; clo = cnt; } else { hi = mid; chi = cnt; }
        }
        int base = 0, eqleft = (clo == 256) ? 512 : 256 - chi;
#pragma unroll
        for (int j = 0; j < 6; ++j) {
          const bool gt = dv[j] > lo, eq = dv[j] == lo;
          const u64 meq = __ballot(eq);
          const bool take = gt || (eq && mbcnt64(meq) < eqleft);
          const u64 mt = __ballot(take);
          if (take) sel[base + mbcnt64(mt)] = (u16)dk[j];
          base += __builtin_popcountll(mt);
          eqleft -= min((int)__builtin_popcountll(meq), eqleft);
        }
      } else {
        int base = 0, eqleft = 256 - chi;
#pragma unroll
        for (int gq = 0; gq < 4; ++gq) {
          if (gq * 16 < ni) {
#pragma unroll
            for (int j = 0; j < 16; ++j) {
              const int i = gq * 16 + j;
              const bool gt = v[i] > lo, eq = v[i] == lo;
              const u64 meq = __ballot(eq);
              const bool take = gt || (eq && mbcnt64(meq) < eqleft);
              const u64 mt = __ballot(take);
              if (take) sel[base + mbcnt64(mt)] = (u16)(i * 64 + lane);
              base += __builtin_popcountll(mt);
              eqleft -= min((int)__builtin_popcountll(meq), eqleft);
              if ((j & 3) == 3) __builtin_amdgcn_sched_barrier(0);
            }
          }
        }
      }
    }
    {
      const long token = tokbase + t;
      const int hd = lane & 15, g4 = lane >> 4;
      bf16x8 qf[4];
#pragma unroll
      for (int ks = 0; ks < 4; ++ks) {
        if (hd < 8) qf[ks] = *(const bf16x8*)(ql + token * 1024 + hd * 128 + 32 * ks + 8 * g4);
        else { for (int e = 0; e < 8; ++e) qf[ks][e] = 0; }
      }
      const int nch = (count + 31) >> 5;
      f32x4 o[8];
#pragma unroll
      for (int c = 0; c < 8; ++c) o[c] = (f32x4){0.f, 0.f, 0.f, 0.f};
      float mrun = -1e30f, lsum = 0.f;
      const int qd = (lane & 15) >> 2, pq = lane & 3;
      bf16x8 kr[8];
#define LOADK32(JJ) do { \
        _Pragma("unroll") for (int j = 0; j < 8; ++j) { \
          const int key_ = sel[32 * (JJ) + 4 * j + g4]; \
          kr[j] = *(const bf16x8*)(cn + (tokbase + key_) * 128 + 8 * hd); \
        } } while (0)
      LOADK32(0);
      for (int jj = 0; jj < nch; ++jj) {
#pragma unroll
        for (int j = 0; j < 8; ++j) *(bf16x8*)(reg + (4 * j + g4) * KROW + hd * 16) = kr[j];
        __builtin_amdgcn_sched_barrier(0);
        if (jj + 1 < nch) LOADK32(jj + 1);
        __builtin_amdgcn_sched_barrier(0);
        f32x4 sacc[2];
#pragma unroll
        for (int tt = 0; tt < 2; ++tt) {
          sacc[tt] = (f32x4){0.f, 0.f, 0.f, 0.f};
#pragma unroll
          for (int ks = 0; ks < 4; ++ks) {
            const bf16x8 kfr = *(const bf16x8*)(reg + (16 * tt + hd) * KROW + (32 * ks + 8 * g4) * 2);
            sacc[tt] = __builtin_amdgcn_mfma_f32_16x16x32_bf16(kfr, qf[ks], sacc[tt], 0, 0, 0);
          }
        }
        if (32 * jj + 32 > count) {
#pragma unroll
          for (int tt = 0; tt < 2; ++tt)
#pragma unroll
            for (int i = 0; i < 4; ++i) {
              const int slot = 32 * jj + 16 * tt + 4 * g4 + i;
              if (slot >= count) sacc[tt][i] = -1e30f;
            }
        }
        float mloc = fmaxf(fmaxf(fmaxf(sacc[0][0], sacc[0][1]), fmaxf(sacc[0][2], sacc[0][3])),
                           fmaxf(fmaxf(sacc[1][0], sacc[1][1]), fmaxf(sacc[1][2], sacc[1][3])));
        mloc = fmaxf(mloc, __shfl_xor(mloc, 16));
        mloc = fmaxf(mloc, __shfl_xor(mloc, 32));
        const float mnew = fmaxf(mrun, mloc);
        const float alpha = __builtin_amdgcn_exp2f(mrun - mnew);
        mrun = mnew;
        float pv[8];
#pragma unroll
        for (int tt = 0; tt < 2; ++tt)
#pragma unroll
          for (int i = 0; i < 4; ++i) pv[tt * 4 + i] = __builtin_amdgcn_exp2f(sacc[tt][i] - mnew);
        const float ps = ((pv[0] + pv[1]) + (pv[2] + pv[3])) + ((pv[4] + pv[5]) + (pv[6] + pv[7]));
        bf16x8 pb;
        {
          unsigned* pw = (unsigned*)&pb;
          pw[0] = pack2(pv[0], pv[1]); pw[1] = pack2(pv[2], pv[3]); pw[2] = pack2(pv[4], pv[5]); pw[3] = pack2(pv[6], pv[7]);
        }
        lsum = lsum * alpha + ps;
#pragma unroll
        for (int c = 0; c < 8; ++c) { o[c][0] *= alpha; o[c][1] *= alpha; o[c][2] *= alpha; o[c][3] *= alpha; }
#pragma unroll
        for (int c = 0; c < 8; ++c) {
          const unsigned a_lo = (unsigned)(size_t)(reg) ;
          (void)a_lo;
          s16x4 lo = __builtin_amdgcn_ds_read_tr16_b64_v4i16(
              (s16x4 __attribute__((address_space(3)))*)(reg + (4 * g4 + qd) * KROW + (16 * c + 4 * pq) * 2));
          s16x4 hi = __builtin_amdgcn_ds_read_tr16_b64_v4i16(
              (s16x4 __attribute__((address_space(3)))*)(reg + (16 + 4 * g4 + qd) * KROW + (16 * c + 4 * pq) * 2));
          bf16x8 vf;
          vf[0] = lo[0]; vf[1] = lo[1]; vf[2] = lo[2]; vf[3] = lo[3];
          vf[4] = hi[0]; vf[5] = hi[1]; vf[6] = hi[2]; vf[7] = hi[3];
          o[c] = __builtin_amdgcn_mfma_f32_16x16x32_bf16(vf, pb, o[c], 0, 0, 0);
        }
      }
      lsum += __shfl_xor(lsum, 16);
      lsum += __shfl_xor(lsum, 32);
      const float inv = 1.f / lsum;
      if (hd < 8) {
#pragma unroll
        for (int c = 0; c < 8; ++c) {
          uint2 pk;
          pk.x = pack2(o[c][0] * inv, o[c][1] * inv);
          pk.y = pack2(o[c][2] * inv, o[c][3] * inv);
          *(uint2*)(ql + token * 1024 + hd * 128 + 16 * c + 4 * g4) = pk;
        }
      }
    }
  }
}

__device__ __forceinline__ void run_epilogue(const Params& p, int l, int epi, int b, int row0, int col0, int tid, const float* sC, int ncols) {
  char* ws = p.ws;
  switch (epi) {
    case 0: { EpiInProj e{(u16*)(ws + OFF_QB), (u16*)(ws + OFF_QI), (u16*)(ws + OFF_KI), (u16*)(ws + OFF_SGA), (u16*)(ws + OFF_SGS),
                          (u16*)(ws + OFF_UGM), (u16*)(ws + OFF_CN), (float*)(ws + OFF_WI), p.kvg + l * 128};
              e.run(b, row0, col0, tid, sC, ncols); } break;
    case 1: { EpiQlat e{(u16*)(ws + OFF_QL)}; e.run(b, row0, col0, tid, sC, ncols); } break;
    case 2: { EpiS e{(float*)(ws + OFF_S)}; e.run(b, row0, col0, tid, sC, ncols); } break;
    case 3: { EpiUv e{(const u16*)(ws + OFF_SGA), (u16*)(ws + OFF_XB)}; e.run(b, row0, col0, tid, sC, ncols); } break;
    case 4: { EpiY e{(const u16*)(ws + OFF_UGM), p.d_skip + l * 512, (u16*)(ws + OFF_QB)}; e.run(b, row0, col0, tid, sC, ncols); } break;
    case 5: { EpiGlu e{(const u16*)(ws + OFF_SGS), p.b_glu + l * 1024, (u16*)(ws + OFF_XB)}; e.run(b, row0, col0, tid, sC, ncols); } break;
    default: { EpiOut e{p.x, p.out, (const float*)(ws + OFF_STATS), p.ln_g + (l > 0 ? l - 1 : 0) * DM, p.ln_b + (l > 0 ? l - 1 : 0) * DM, l == 0 ? 1 : 0};
               e.run(b, row0, col0, tid, sC, ncols); } break;
  }
}

__device__ __forceinline__ void make_desc(GemmDesc& d, const Params& p, int l, int op) {
  char* ws = p.ws;
  d.A2 = nullptr; d.a2_bs = 0; d.lda2 = 0; d.ksplit = 1 << 30;
  switch (op) {
    case 0:
      d.A = (const u16*)(ws + OFF_XB); d.lda = DM; d.a_bs = 0;
      d.Bt = (const u16*)(ws + OFF_WINT) + (long)l * NPAD * DM; d.ldb = DM; d.b_bs = 0;
      d.M = NTOK; d.N = NPAD; d.K = DM; d.nbatch = 1; break;
    case 1:
      d.A = (const u16*)(ws + OFF_QB); d.lda = 512; d.a_bs = 64;
      d.Bt = (const u16*)(ws + OFF_WUK) + (long)l * 8 * 128 * 64; d.ldb = 64; d.b_bs = 128 * 64;
      d.M = NTOK; d.N = 128; d.K = 64; d.nbatch = 8; break;
    case 2:
      d.A = (const u16*)(ws + OFF_UGM); d.lda = 256; d.a_bs = (long)NTOK * 16;
      d.Bt = (const u16*)(ws + OFF_OP1) + (long)l * NGRP * 128 * 256; d.ldb = 256; d.b_bs = 128 * 256;
      d.M = NCHUNK; d.N = 128; d.K = 256; d.nbatch = NGRP; break;
    case 3:
      d.A = (const u16*)(ws + OFF_QL); d.lda = 1024; d.a_bs = 256;
      d.Bt = (const u16*)(ws + OFF_WUVP) + (long)l * 4 * 128 * 256; d.ldb = 256; d.b_bs = 128 * 256;
      d.M = NTOK; d.N = 128; d.K = 256; d.nbatch = 4; break;
    case 4:
      d.A = (const u16*)(ws + OFF_UGM); d.lda = 256; d.a_bs = (long)NTOK * 16;
      d.A2 = (const u16*)(ws + OFF_CKV); d.lda2 = 128; d.a2_bs = (long)NCHUNK * 128; d.ksplit = 256;
      d.Bt = (const u16*)(ws + OFF_OP2) + (long)l * NGRP * 256 * 384; d.ldb = 384; d.b_bs = 256 * 384;
      d.M = NCHUNK; d.N = 256; d.K = 384; d.nbatch = NGRP; break;
    case 5:
      d.A = (const u16*)(ws + OFF_QB); d.lda = 512; d.a_bs = 0;
      d.Bt = (const u16*)(ws + OFF_WGLUT) + (long)l * 1024 * 512; d.ldb = 512; d.b_bs = 0;
      d.M = NTOK; d.N = 1024; d.K = 512; d.nbatch = 1; break;
    default:
      d.A = (const u16*)(ws + OFF_XB); d.lda = DM; d.a_bs = 0;
      d.Bt = (const u16*)(ws + OFF_WOUTT) + (long)l * DM * DM; d.ldb = DM; d.b_bs = 0;
      d.M = NTOK; d.N = DM; d.K = DM; d.nbatch = 1; break;
  }
}

__device__ __forceinline__ void run_phase(const Params& p, int ph, int wid0, char* smem) {
  Ctx cx; cx.bid = blockIdx.x; cx.G = gridDim.x;
  {
    int wid_s = wid0; OPAQUE_S(wid_s);
    cx.tid = wid_s * 64 + (int)__builtin_amdgcn_mbcnt_hi(~0u, __builtin_amdgcn_mbcnt_lo(~0u, 0u));
  }
  OPAQUE_V(cx.tid); OPAQUE_S(cx.bid); OPAQUE_S(cx.G);
  if (ph == 0) { prologue_phase(cx, p, smem); return; }
  const int l = (ph - 1) / 7, s = (ph - 1) % 7;
  int op0 = -1, nops = 0;
  if (s == 0) { op0 = 0; nops = 1; }
  else if (s == 1) { op0 = 1; nops = 2; }
  else if (s == 3) { op0 = 3; nops = 2; }
  else if (s == 4) { op0 = 5; nops = 1; }
  else if (s == 5) { op0 = 6; nops = 1; }
  for (int i = 0; i < nops; ++i) {
    GemmDesc d;
    make_desc(d, p, l, op0 + i);
    gemm_phase(cx, d, op0 + i, p, l, smem);
  }

  if (s == 2) { scan_pass(cx, p, l); attn_phase(cx, p, smem); }
  if (s == 6) layernorm_pass(cx, p, l);
}

__global__ void __launch_bounds__(NTHR, 2) hymba_megakernel(Params p) {
  __shared__ __attribute__((aligned(16))) char smem[SMEM_BYTES];
  cg::grid_group grid = cg::this_grid();
  const int wid0 = __builtin_amdgcn_readfirstlane((int)(threadIdx.x >> 6));
  for (int ph = p.phase_lo; ph < p.phase_hi; ++ph) {
    run_phase(p, ph, wid0, smem);
    if (ph + 1 < p.phase_hi) grid.sync();
  }
}

#ifndef MULTI_LAUNCH
#define MULTI_LAUNCH 0
#endif

extern "C" void kernel_launch(void* const* d_in, const int* in_sizes, int n_in, void* d_out, int out_size, void* d_ws, size_t ws_size,
                              hipStream_t stream) {
  static int grid_blocks = 0;
  if (!grid_blocks) {
    int dev = 0, cus = 0, per_cu = 0;
    hipGetDevice(&dev);
    hipDeviceGetAttribute(&cus, hipDeviceAttributeMultiprocessorCount, dev);
    hipOccupancyMaxActiveBlocksPerMultiprocessor(&per_cu, hymba_megakernel, NTHR, 0);
    if (per_cu > 1) per_cu = 1;
    if (per_cu < 1) per_cu = 1;
    grid_blocks = cus * per_cu;
  }
  Params p{};
  p.x = (const float*)d_in[0]; p.w_in = (const float*)d_in[1]; p.kvg = (const float*)d_in[2]; p.w_uk = (const float*)d_in[3];
  p.w_uv = (const float*)d_in[4]; p.log_dt = (const float*)d_in[5]; p.a_re = (const float*)d_in[6]; p.a_im = (const float*)d_in[7];
  p.b_re = (const float*)d_in[8]; p.b_im = (const float*)d_in[9]; p.c_re = (const float*)d_in[10]; p.c_im = (const float*)d_in[11];
  p.d_skip = (const float*)d_in[12]; p.w_glu = (const float*)d_in[13]; p.b_glu = (const float*)d_in[14]; p.w_out = (const float*)d_in[15];
  p.ln_g = (const float*)d_in[16]; p.ln_b = (const float*)d_in[17];
  p.out = (float*)d_out; p.ws = (char*)d_ws;
  const int nph = 1 + 7 * DEPTH;
#if MULTI_LAUNCH
  for (int ph = 0; ph < nph; ++ph) {
    p.phase_lo = ph; p.phase_hi = ph + 1;
    hipLaunchKernelGGL(hymba_megakernel, dim3(grid_blocks), dim3(NTHR), 0, stream, p);
  }
#else
  p.phase_lo = 0; p.phase_hi = nph;
  void* args[] = {&p};
  hipError_t e = hipLaunchCooperativeKernel((void*)hymba_megakernel, dim3(grid_blocks), dim3(NTHR), args, 0, stream);
  if (e != hipSuccess) fprintf(stderr, "cooperative launch failed: %s (grid %d)\n", hipGetErrorString(e), grid_blocks);
#endif
}
```

```cpp
#include <hip/hip_runtime.h>
#include <hip/hip_bf16.h>
#include <hip/hip_cooperative_groups.h>
#include <cstdio>
namespace cg = cooperative_groups;

typedef __attribute__((ext_vector_type(8))) short bf16x8;
typedef __attribute__((ext_vector_type(4))) short s16x4;
typedef __attribute__((ext_vector_type(4))) float f32x4;
typedef __attribute__((ext_vector_type(16))) float f32x16;
typedef unsigned short u16;
typedef unsigned long long u64;

#define NTOK 65536
#define SEQL 4096
#define NBATCH 16
#define DM 1024
#define DIN 2472
#define NPAD 2560
#define DEPTH 4
#define NGRP 32
#define TCH 16
#define NCHUNK 4096
#define ALPHA 1.681792830507429f
#define SMEM_BYTES 151552
#define NTHR 512
#define NWV 8
#define REG_STRIDE 18944
#define KROW 272

#define MiB (1024ull * 1024ull)
#define OFF_XB    (0ull)
#define OFF_QB    (128 * MiB)
#define OFF_CKV   (192 * MiB)
#define OFF_CN    (224 * MiB)
#define OFF_QI    (240 * MiB)
#define OFF_KI    (272 * MiB)
#define OFF_WI    (276 * MiB)
#define OFF_SGA   (278 * MiB)
#define OFF_SGS   (342 * MiB)
#define OFF_UGM   (406 * MiB)
#define OFF_QL    (470 * MiB)
#define OFF_S     (598 * MiB)
#define OFF_STATS (662 * MiB)
#define OFF_WINT  (663 * MiB)
#define OFF_WOUTT (683 * MiB)
#define OFF_WGLUT (691 * MiB)
#define OFF_WUK   (695 * MiB)
#define OFF_WUVP  (696 * MiB)
#define OFF_OP1   (697 * MiB)
#define OFF_OP2   (705 * MiB)
#define OFF_AT    (729 * MiB)

struct Params {
  const float *x, *w_in, *kvg, *w_uk, *w_uv, *log_dt, *a_re, *a_im, *b_re, *b_im, *c_re, *c_im, *d_skip, *w_glu, *b_glu, *w_out, *ln_g, *ln_b;
  float* out;
  char* ws;
  int phase_lo, phase_hi;
};

struct Ctx { int tid, bid, G; };
#define OPAQUE_V(x) asm volatile("" : "+v"(x))
#define OPAQUE_S(x) asm volatile("" : "+s"(x))

__device__ __forceinline__ u16 f2bf(float f) {
  unsigned u = __float_as_uint(f);
  u += 0x7fffu + ((u >> 16) & 1u);
  return (u16)(u >> 16);
}
__device__ __forceinline__ float bf2f(u16 h) { return __uint_as_float(((unsigned)h) << 16); }
typedef __attribute__((ext_vector_type(2))) __bf16 bf16x2_t;
typedef __attribute__((ext_vector_type(2))) float f32x2_t;
__device__ __forceinline__ unsigned pack2(float a, float b) {
  f32x2_t v = {a, b};
  bf16x2_t r = __builtin_convertvector(v, bf16x2_t);
  return *(unsigned*)&r;
}
__device__ __forceinline__ float sigmoid_fast(float v) { return __builtin_amdgcn_rcpf(1.f + __builtin_amdgcn_exp2f(-1.4426950408889634f * v)); }
__device__ __forceinline__ float silu_f(float v) { return v * sigmoid_fast(v); }
__device__ __forceinline__ float gelu_tanh(float y) {
  float t = 0.7978845608028654f * (y + 0.044715f * y * y * y);
  return y * sigmoid_fast(2.f * t);
}

struct GemmDesc {
  const u16* A; const u16* A2; const u16* Bt;
  long a_bs, a2_bs, b_bs;
  int lda, lda2, ldb, ksplit;
  int M, N, K, nbatch;
};

#define LDT 72
#define CLD 132

__device__ __forceinline__ void run_epilogue(const Params& p, int l, int epi, int b, int row0, int col0, int tid, const float* sC, int ncols);

__device__ __forceinline__ void gemm_phase(const Ctx& cx, const GemmDesc& d, int epi, const Params& p, int l, char* smem) {
  const int tid = cx.tid, lane = tid & 63, wid = __builtin_amdgcn_readfirstlane(tid >> 6), wr = wid >> 2, wc = wid & 3;
  const int nM = d.M >> 8, nN = (d.N + 255) >> 8, nk = d.K >> 6;
  const int T = d.nbatch * nM * nN;
  const int G = cx.G, bid = cx.bid;
  int start, step, end;
  if ((G & 7) == 0) {
    int per = G >> 3, chunk = (T + 7) >> 3, xcd = bid & 7;
    start = xcd * chunk + (bid >> 3); step = per; end = min(T, (xcd + 1) * chunk);
  } else { start = bid; step = G; end = T; }
  const int lrow = lane >> 3;
  const int lsrc0 = ((lane & 7) ^ ((lane >> 4) & 7)) * 8;
  const int lsrc1 = ((lane & 7) ^ ((4 + (lane >> 4)) & 7)) * 8;
  const int fsw = (lane >> 1) & 7;
  const int ncols = min(256, d.N);
  const bool active = wc * 64 < ncols;
  bool prefetched = false;
  for (int t = start; t < end; t += step) {
#define TILE_DECODE(t_, m_, n_, b_, Ab_, A2b_, Bb_) do { \
      const int grp_ = (t_) / (4 * nN), rem_ = (t_) - grp_ * (4 * nN); \
      n_ = rem_ >> 2; const int r_ = grp_ * 4 + (rem_ & 3); m_ = r_ % nM; b_ = r_ / nM; \
      Ab_ = d.A + (long)b_ * d.a_bs + (long)(m_ * 256) * d.lda; \
      A2b_ = d.A2 ? d.A2 + (long)b_ * d.a2_bs + (long)(m_ * 256) * d.lda2 : nullptr; \
      Bb_ = d.Bt + (long)b_ * d.b_bs + (long)(n_ * 256) * d.ldb; \
    } while (0)
    int m, n, b; const u16 *Ab, *A2b, *Bb;
    TILE_DECODE(t, m, n, b, Ab, A2b, Bb);
    f32x4 acc[8][4];
#pragma unroll
    for (int i = 0; i < 8; ++i)
#pragma unroll
      for (int j = 0; j < 4; ++j) acc[i][j] = (f32x4){0.f, 0.f, 0.f, 0.f};
#define STAGE(kt_, s_) do { \
      const int k0_ = (kt_) * 64; \
      const u16* ap_; long ld_; \
      if (k0_ < d.ksplit) { ap_ = Ab + k0_; ld_ = d.lda; } else { ap_ = A2b + (k0_ - d.ksplit); ld_ = d.lda2; } \
      char* sa_ = smem + (s_) * 65536; \
      _Pragma("unroll") for (int j = 0; j < 4; ++j) { \
        const int g_ = wid * 4 + j;     \
        const int ls_ = (j & 1) ? lsrc1 : lsrc0; \
        __builtin_amdgcn_global_load_lds((const unsigned*)(ap_ + (long)(g_ * 8 + lrow) * ld_ + ls_), \
                                         (unsigned*)(sa_ + g_ * 1024 + lane * 16), 16, 0, 0); \
        const int br_ = (g_ * 8 + lrow) & (ncols - 1);     \
        __builtin_amdgcn_global_load_lds((const unsigned*)(Bb + (long)br_ * d.ldb + k0_ + ls_), \
                                         (unsigned*)(sa_ + 32768 + g_ * 1024 + lane * 16), 16, 0, 0); \
      } \
    } while (0)
    if (!prefetched) STAGE(0, 0);
    asm volatile("s_waitcnt vmcnt(0)" ::: "memory");
    __builtin_amdgcn_s_barrier();
    const int arow = (wr * 128 + (lane & 15)) * 128, brow = 32768 + (wc * 64 + (lane & 15)) * 128;
    for (int kt = 0; kt < nk; ++kt) {
      const int s = kt & 1;
      if (kt + 1 < nk) STAGE(kt + 1, s ^ 1);
      if (active) {
        const char* sb = smem + s * 65536;
#pragma unroll 1
        for (int kh = 0; kh < 2; ++kh) {
          bf16x8 fa[8], fb[4];
          const int co = (((4 * kh + (lane >> 4)) ^ fsw) * 16);
#pragma unroll
          for (int nt = 0; nt < 4; ++nt) fb[nt] = *(const bf16x8*)(sb + brow + nt * 16 * 128 + co);
          fa[0] = *(const bf16x8*)(sb + arow + co);
          fa[1] = *(const bf16x8*)(sb + arow + 16 * 128 + co);
          __builtin_amdgcn_sched_barrier(0);
          acc[0][0] = __builtin_amdgcn_mfma_f32_16x16x32_bf16(fb[0], fa[0], acc[0][0], 0, 0, 0);
          __builtin_amdgcn_sched_barrier(0);
#pragma unroll
          for (int mt = 2; mt < 8; ++mt) fa[mt] = *(const bf16x8*)(sb + arow + mt * 16 * 128 + co);
          __builtin_amdgcn_sched_barrier(0);
#pragma unroll
          for (int nt = 1; nt < 4; ++nt)
            acc[0][nt] = __builtin_amdgcn_mfma_f32_16x16x32_bf16(fb[nt], fa[0], acc[0][nt], 0, 0, 0);
#pragma unroll
          for (int nt = 0; nt < 4; ++nt)
            acc[1][nt] = __builtin_amdgcn_mfma_f32_16x16x32_bf16(fb[nt], fa[1], acc[1][nt], 0, 0, 0);
          __builtin_amdgcn_sched_barrier(0);
#pragma unroll
          for (int mt = 2; mt < 8; ++mt)
#pragma unroll
            for (int nt = 0; nt < 4; ++nt)
              acc[mt][nt] = __builtin_amdgcn_mfma_f32_16x16x32_bf16(fb[nt], fa[mt], acc[mt][nt], 0, 0, 0);
          __builtin_amdgcn_sched_barrier(0);
        }
      }
      asm volatile("s_waitcnt vmcnt(0)" ::: "memory");
      __builtin_amdgcn_s_barrier();
    }
    const int m_cur = m, n_cur = n, b_cur = b;
    prefetched = false;
    if (t + step < end && (nk & 1) == 0) {
      TILE_DECODE(t + step, m, n, b, Ab, A2b, Bb);
      STAGE(0, 0);
      prefetched = true;
    }
    float* sC = (float*)(smem + 65536);
#pragma unroll
    for (int q = 0; q < 2; ++q)
#pragma unroll
      for (int ch = 0; ch < 2; ++ch) {
        if (ch * 128 < ncols) {
          if (q | ch) __syncthreads();
          if (active && (wc >> 1) == ch) {
#pragma unroll
            for (int mt2 = 0; mt2 < 4; ++mt2)
#pragma unroll
              for (int nt = 0; nt < 4; ++nt)
                *(f32x4*)(sC + (wr * 64 + mt2 * 16 + (lane & 15)) * CLD + (wc & 1) * 64 + nt * 16 + 4 * (lane >> 4)) = acc[4 * q + mt2][nt];
          }
          __syncthreads();
          run_epilogue(p, l, epi, b_cur, m_cur * 256 + q * 64, n_cur * 256 + ch * 128, tid, sC, 128);
        }
      }
  }
}

__device__ __forceinline__ uint2 pack4(float4 v) {
  uint2 pk;
  pk.x = pack2(v.x, v.y);
  pk.y = pack2(v.z, v.w);
  return pk;
}
__device__ __forceinline__ float4 unpack4(uint2 u) {
  float4 v;
  v.x = __uint_as_float(u.x << 16); v.y = __uint_as_float(u.x & 0xffff0000u);
  v.z = __uint_as_float(u.y << 16); v.w = __uint_as_float(u.y & 0xffff0000u);
  return v;
}
template <class F>
__device__ __forceinline__ void epi_each(int row0, int col0, int tid, const float* sC, int ncols, const F& f) {
#pragma unroll 2
  for (int j = 0; j < 8; ++j) {
    const int e = tid + NTHR * j;
    const int r = e >> 5, c = (e & 31) * 4;
    const float4 v = *(const float4*)(sC + r * CLD + c);
    f(row0 + r + (r & 64), col0 + c, v);
  }
}

struct EpiInProj {
  u16 *qb, *qi, *ki, *sga, *sgs, *ugm, *cn; float *wi; const float* kvg;
  __device__ __forceinline__ void run(int b, int row0, int col0, int tid, const float* sC, int ncols) const {
    const EpiInProj& s = *this;
    if (col0 == 512) {
      const int lane = tid & 63;
      const float4 gv = *(const float4*)(s.kvg + (lane & 31) * 4);
#pragma unroll 2
      for (int j = 0; j < 8; ++j) {
        const int e = tid + NTHR * j;
        const int r = e >> 5, c = (e & 31) * 4;
        const float4 v = *(const float4*)(sC + r * CLD + c);
        const long row = row0 + r + (r & 64);
        float ss = v.x * v.x + v.y * v.y + v.z * v.z + v.w * v.w;
        ss += __shfl_xor(ss, 16); ss += __shfl_xor(ss, 8); ss += __shfl_xor(ss, 4); ss += __shfl_xor(ss, 2); ss += __shfl_xor(ss, 1);
        const float rs = rsqrtf(ss * (1.f / 128.f) + 1e-6f);
        float4 w; w.x = v.x * rs * gv.x; w.y = v.y * rs * gv.y; w.z = v.z * rs * gv.z; w.w = v.w * rs * gv.w;
        *(uint2*)(s.cn + row * 128 + c) = pack4(w);
      }
      return;
    }
    epi_each(row0, col0, tid, sC, ncols, [&](int row, int col, float4 v) {
      if (col < 512) *(uint2*)(s.qb + (long)row * 512 + col) = pack4(v);
      else if (col < 896) *(uint2*)(s.qi + (long)row * 256 + (col - 640)) = pack4(v);
      else if (col < 928) *(uint2*)(s.ki + (long)row * 32 + (col - 896)) = pack4(v);
      else if (col < 936) { float4 w = v; w.x *= 0.0625f; w.y *= 0.0625f; w.z *= 0.0625f; w.w *= 0.0625f; *(float4*)(s.wi + (long)row * 8 + (col - 928)) = w; }
      else if (col < 1024) {}
      else if (col < 1536) { float4 w; w.x = silu_f(v.x); w.y = silu_f(v.y); w.z = silu_f(v.z); w.w = silu_f(v.w); *(uint2*)(s.sga + (long)row * 512 + (col - 1024)) = pack4(w); }
      else if (col < 2048) { int cc = col - 1536; *(uint2*)(s.ugm + ((long)(cc >> 4) * NTOK + row) * 16 + (cc & 15)) = pack4(v); }
      else { float4 w; w.x = silu_f(v.x); w.y = silu_f(v.y); w.z = silu_f(v.z); w.w = silu_f(v.w); *(uint2*)(s.sgs + (long)row * 512 + (col - 2048)) = pack4(w); }
    });
  }
};
struct EpiQlat {
  u16* ql;
  __device__ __forceinline__ void run(int b, int row0, int col0, int tid, const float* sC, int ncols) const {
    u16* o = ql;
    epi_each(row0, col0, tid, sC, ncols, [&](int row, int col, float4 v) { *(uint2*)(o + (long)row * 1024 + b * 128 + col) = pack4(v); });
  }
};
struct EpiS {
  float* S;
  __device__ __forceinline__ void run(int b, int row0, int col0, int tid, const float* sC, int ncols) const {
    float* o = S;
    epi_each(row0, col0, tid, sC, ncols, [&](int row, int col, float4 v) { *(float4*)(o + ((long)b * NCHUNK + row) * 128 + col) = v; });
  }
};
struct EpiUv {
  const u16* sga; u16* mixed;
  __device__ __forceinline__ void run(int b, int row0, int col0, int tid, const float* sC, int ncols) const {
    const u16* g = sga; u16* o = mixed;
    epi_each(row0, col0, tid, sC, ncols, [&](int row, int col, float4 v) {
      int c2 = b * 128 + col;
      float4 gv = unpack4(*(const uint2*)(g + (long)row * 512 + c2));
      float4 w; w.x = v.x * gv.x; w.y = v.y * gv.y; w.z = v.z * gv.z; w.w = v.w * gv.w;
      *(uint2*)(o + (long)row * 1024 + c2) = pack4(w);
    });
  }
};
struct EpiY {
  const u16* ugm; const float* dsk; u16* yact;
  __device__ __forceinline__ void run(int b, int row0, int col0, int tid, const float* sC, int ncols) const {
    const u16* u = ugm; const float* dd = dsk; u16* o = yact;
    epi_each(row0, col0, tid, sC, ncols, [&](int row, int col, float4 v) {
      int t = col >> 4, c = col & 15;
      long token = (long)row * TCH + t;
      float4 uv = unpack4(*(const uint2*)(u + ((long)b * NTOK + token) * 16 + c));
      float4 dv = *(const float4*)(dd + b * 16 + c);
      float4 w;
      w.x = gelu_tanh(v.x + dv.x * uv.x); w.y = gelu_tanh(v.y + dv.y * uv.y);
      w.z = gelu_tanh(v.z + dv.z * uv.z); w.w = gelu_tanh(v.w + dv.w * uv.w);
      *(uint2*)(o + token * 512 + b * 16 + c) = pack4(w);
    });
  }
};
struct EpiGlu {
  const u16* sgs; const float* bglu; u16* mixed;
  __device__ __forceinline__ void run(int b, int row0, int col0, int tid, const float* sC, int ncols) const {
#pragma unroll 2
    for (int jj = 0; jj < 4; ++jj) {
      const int e = tid + NTHR * jj;
      const int r = e >> 4, q = e & 15, gi = q >> 3, qq = q & 7;
      const float4 va = *(const float4*)(sC + r * CLD + gi * 64 + qq * 4);
      const float4 ga = *(const float4*)(sC + r * CLD + gi * 64 + 32 + qq * 4);
      const int j = (col0 >> 1) + gi * 32 + qq * 4;
      const long row = row0 + r + (r & 64);
      const float4 bv = *(const float4*)(bglu + j), bg = *(const float4*)(bglu + 512 + j);
      const float4 sg = unpack4(*(const uint2*)(sgs + row * 512 + j));
      float4 w;
      w.x = (va.x + bv.x) * sigmoid_fast(ga.x + bg.x) * sg.x;
      w.y = (va.y + bv.y) * sigmoid_fast(ga.y + bg.y) * sg.y;
      w.z = (va.z + bv.z) * sigmoid_fast(ga.z + bg.z) * sg.z;
      w.w = (va.w + bv.w) * sigmoid_fast(ga.w + bg.w) * sg.w;
      *(uint2*)(mixed + row * 1024 + 512 + j) = pack4(w);
    }
  }
};
struct EpiOut {
  const float* xin; float* z; const float* stats; const float* g; const float* bb; int first;
  __device__ __forceinline__ void run(int b, int row0, int col0, int tid, const float* sC, int ncols) const {
    const EpiOut& s = *this;
    epi_each(row0, col0, tid, sC, ncols, [&](int row, int col, float4 v) {
      long idx = (long)row * 1024 + col;
      float4 xp;
      if (s.first) xp = *(const float4*)(s.xin + idx);
      else {
        float mu = s.stats[2 * row], rs = s.stats[2 * row + 1];
        float4 zo = *(const float4*)(s.z + idx), gv = *(const float4*)(s.g + col), bv = *(const float4*)(s.bb + col);
        xp.x = (zo.x - mu) * rs * gv.x + bv.x; xp.y = (zo.y - mu) * rs * gv.y + bv.y;
        xp.z = (zo.z - mu) * rs * gv.z + bv.z; xp.w = (zo.w - mu) * rs * gv.w + bv.w;
      }
      float4 o; o.x = ALPHA * xp.x + v.x; o.y = ALPHA * xp.y + v.y; o.z = ALPHA * xp.z + v.z; o.w = ALPHA * xp.w + v.w;
      *(float4*)(s.z + idx) = o;
    });
  }
};

template <class CM>
__device__ __forceinline__ void transpose_tile(const Ctx& cx, const float* src, int sld, u16* dst, int dld, int k0, int n0, const CM& colmap, char* smem) {
  float* tile = (float*)smem;
  const int tid = cx.tid;
  __syncthreads();
  for (int e = tid; e < 4096; e += NTHR) {
    int kk = e >> 6, nn = e & 63;
    int sc = colmap(n0 + nn);
    tile[kk * 65 + nn] = sc >= 0 ? src[(long)(k0 + kk) * sld + sc] : 0.f;
  }
  __syncthreads();
  for (int e = tid; e < 4096; e += NTHR) {
    int nn = e >> 6, kk = e & 63;
    dst[(long)(n0 + nn) * dld + k0 + kk] = f2bf(tile[kk * 65 + nn]);
  }
}

__device__ __forceinline__ void ssm_ops(const Ctx& cx, const Params& p, int l, int g, char* smem) {
  float* ap = (float*)smem;
  float* bbm = ap + 17 * 64 * 2;
  float* ccm = bbm + 64 * 16 * 2;
  float* kj = ccm + 16 * 64 * 2;
  const int tid = cx.tid;
  const int lg = l * NGRP + g;
  __syncthreads();
  if (tid < 64) {
    const int pp = tid;
    float dt = expf(p.log_dt[lg]);
    float lr = p.a_re[lg * 64 + pp], li = p.a_im[lg * 64 + pp];
    for (int j = 0; j <= 16; ++j) {
      float mag = expf(lr * dt * (float)j);
      float sn, cs; sincosf(li * dt * (float)j, &sn, &cs);
      ap[(j * 64 + pp) * 2] = mag * cs; ap[(j * 64 + pp) * 2 + 1] = mag * sn;
    }
    float ar = ap[(1 * 64 + pp) * 2], ai = ap[(1 * 64 + pp) * 2 + 1];
    float den = lr * lr + li * li;
    float cr = ((ar - 1.f) * lr + ai * li) / den;
    float ci = (ai * lr - (ar - 1.f) * li) / den;
    for (int c = 0; c < 16; ++c) {
      float br = p.b_re[((long)lg * 64 + pp) * 16 + c], bi = p.b_im[((long)lg * 64 + pp) * 16 + c];
      bbm[(pp * 16 + c) * 2] = cr * br - ci * bi;
      bbm[(pp * 16 + c) * 2 + 1] = cr * bi + ci * br;
    }
    float* at = (float*)(p.ws + OFF_AT) + ((long)lg * 64 + pp) * 2;
    at[0] = ap[(16 * 64 + pp) * 2]; at[1] = ap[(16 * 64 + pp) * 2 + 1];
  }
  for (int e = tid; e < 1024; e += NTHR) {
    ccm[e * 2] = p.c_re[(long)lg * 1024 + e];
    ccm[e * 2 + 1] = p.c_im[(long)lg * 1024 + e];
  }
  __syncthreads();
  for (int e = tid; e < 4096; e += NTHR) {
    int j = e >> 8, cp = (e >> 4) & 15, c = e & 15;
    float s = 0.f;
    for (int pp = 0; pp < 64; ++pp) {
      float c_r = ccm[(cp * 64 + pp) * 2], c_i = ccm[(cp * 64 + pp) * 2 + 1];
      float a_r = ap[(j * 64 + pp) * 2], a_i = ap[(j * 64 + pp) * 2 + 1];
      float er = c_r * a_r - c_i * a_i, ei = c_r * a_i + c_i * a_r;
      s += er * bbm[(pp * 16 + c) * 2] - ei * bbm[(pp * 16 + c) * 2 + 1];
    }
    kj[e] = s;
  }
  __syncthreads();
  u16* op2 = (u16*)(p.ws + OFF_OP2) + (long)lg * 256 * 384;
  for (int e = tid; e < 256 * 384; e += NTHR) {
    int n = e / 384, k = e - n * 384;
    int t = n >> 4, cp = n & 15;
    float v;
    if (k < 256) {
      int s = k >> 4, c = k & 15;
      v = (s <= t) ? kj[((t - s) * 16 + cp) * 16 + c] : 0.f;
    } else {
      int j = k - 256, pp = j & 63;
      float c_r = ccm[(cp * 64 + pp) * 2], c_i = ccm[(cp * 64 + pp) * 2 + 1];
      float a_r = ap[((t + 1) * 64 + pp) * 2], a_i = ap[((t + 1) * 64 + pp) * 2 + 1];
      v = (j < 64) ? (c_r * a_r - c_i * a_i) : -(c_r * a_i + c_i * a_r);
    }
    op2[e] = f2bf(v);
  }
  u16* op1 = (u16*)(p.ws + OFF_OP1) + (long)lg * 128 * 256;
  for (int e = tid; e < 128 * 256; e += NTHR) {
    int j = e >> 8, k = e & 255;
    int pp = j & 63, s = k >> 4, c = k & 15;
    float a_r = ap[((15 - s) * 64 + pp) * 2], a_i = ap[((15 - s) * 64 + pp) * 2 + 1];
    float b_r = bbm[(pp * 16 + c) * 2], b_i = bbm[(pp * 16 + c) * 2 + 1];
    float v = (j < 64) ? (a_r * b_r - a_i * b_i) : (a_r * b_i + a_i * b_r);
    op1[e] = f2bf(v);
  }
}

__device__ __forceinline__ void prologue_phase(const Ctx& cx, const Params& p, char* smem) {
  const int G = cx.G, bid = cx.bid, tid = cx.tid;
  for (int it = bid; it < DEPTH * NGRP; it += G) ssm_ops(cx, p, it / NGRP, it % NGRP, smem);
  for (int it = bid; it < DEPTH * 16 * 40; it += G) {
    int l = it / 640, r = it % 640, kt = r / 40, ntile = r % 40;
    transpose_tile(cx, p.w_in + (long)l * DM * DIN, DIN, (u16*)(p.ws + OFF_WINT) + (long)l * NPAD * DM, DM, kt * 64, ntile * 64,
                   [](int n) { return n < 936 ? n : (n < 1024 ? -1 : n - 88); }, smem);
  }
  for (int it = bid; it < DEPTH * 256; it += G) {
    int l = it >> 8, r = it & 255, kt = r >> 4, ntile = r & 15;
    transpose_tile(cx, p.w_out + (long)l * DM * DM, DM, (u16*)(p.ws + OFF_WOUTT) + (long)l * DM * DM, DM, kt * 64, ntile * 64,
                   [](int n) { return n; }, smem);
  }
  for (int it = bid; it < DEPTH * 128; it += G) {
    int l = it >> 7, r = it & 127, kt = r >> 4, ntile = r & 15;
    transpose_tile(cx, p.w_glu + (long)l * 512 * 1024, 1024, (u16*)(p.ws + OFF_WGLUT) + (long)l * 1024 * 512, 512, kt * 64, ntile * 64,
                   [](int n) { return ((n >> 5) & 1) * 512 + (n >> 6) * 32 + (n & 31); }, smem);
  }
  const long gtid = (long)bid * NTHR + tid, gsz = (long)G * NTHR;
  {
    u16* o = (u16*)(p.ws + OFF_WUK);
    for (long e = gtid; e < (long)DEPTH * 8 * 128 * 64; e += gsz) o[e] = f2bf(0.125f * 1.4426950408889634f * p.w_uk[e]);
  }
  {
    u16* o = (u16*)(p.ws + OFF_WUVP);
    for (long e = gtid; e < (long)DEPTH * 4 * 128 * 256; e += gsz) {
      int k = e & 255, n = (e >> 8) & 127, j = (e >> 15) & 3, l = (int)(e >> 17);
      int hh = n >> 6, dd = n & 63, hh2 = k >> 7, c = k & 127;
      float v = (hh == hh2) ? p.w_uv[(((long)l * 8 + 2 * j + hh) * 128 + c) * 64 + dd] : 0.f;
      o[e] = f2bf(v);
    }
  }
  {
    u16* o = (u16*)(p.ws + OFF_XB);
    const float4* xi = (const float4*)p.x;
    for (long e = gtid; e < (long)NTOK * DM / 4; e += gsz) {
      float4 v = xi[e];
      uint2 pk;
      pk.x = pack2(v.x, v.y);
      pk.y = pack2(v.z, v.w);
      *(uint2*)(o + e * 4) = pk;
    }
  }
}

__device__ __forceinline__ void rmsnorm_pass(const Ctx& cx, const Params& p, int l) {
  const float* ckv = (const float*)(p.ws + OFF_CKV);
  u16* cn = (u16*)(p.ws + OFF_CN);
  const float* g = p.kvg + l * 128;
  const int lane = cx.tid & 63, half = lane >> 5, l32 = lane & 31;
  const long gw = (long)cx.bid * NWV + (cx.tid >> 6), nw = (long)cx.G * NWV;
  const float4 gv = *(const float4*)(g + l32 * 4);
  for (long it = gw; it < NTOK / 2; it += nw) {
    long tok = it * 2 + half;
    float4 v = *(const float4*)(ckv + tok * 128 + l32 * 4);
    float ss = v.x * v.x + v.y * v.y + v.z * v.z + v.w * v.w;
    ss += __shfl_xor(ss, 16); ss += __shfl_xor(ss, 8); ss += __shfl_xor(ss, 4); ss += __shfl_xor(ss, 2); ss += __shfl_xor(ss, 1);
    float rs = rsqrtf(ss * (1.f / 128.f) + 1e-6f);
    uint2 pk;
    pk.x = pack2(v.x * rs * gv.x, v.y * rs * gv.y);
    pk.y = pack2(v.z * rs * gv.z, v.w * rs * gv.w);
    *(uint2*)(cn + tok * 128 + l32 * 4) = pk;
  }
}

__device__ __forceinline__ void layernorm_pass(const Ctx& cx, const Params& p, int l) {
  float* z = p.out;
  float* stats = (float*)(p.ws + OFF_STATS);
  u16* xb = (u16*)(p.ws + OFF_XB);
  const float* g = p.ln_g + l * DM; const float* bb = p.ln_b + l * DM;
  const int lane = cx.tid & 63;
  const long gw = (long)cx.bid * NWV + (cx.tid >> 6), nw = (long)cx.G * NWV;
  float4 gv[4], bv[4];
#pragma unroll
  for (int j = 0; j < 4; ++j) { gv[j] = *(const float4*)(g + j * 256 + lane * 4); bv[j] = *(const float4*)(bb + j * 256 + lane * 4); }
  for (long row = gw; row < NTOK; row += nw) {
    float4 v[4];
    float s = 0.f;
#pragma unroll
    for (int j = 0; j < 4; ++j) { v[j] = *(const float4*)(z + row * DM + j * 256 + lane * 4); s += v[j].x + v[j].y + v[j].z + v[j].w; }
#pragma unroll
    for (int o = 32; o >= 1; o >>= 1) s += __shfl_xor(s, o);
    float mu = s * (1.f / 1024.f);
    float q = 0.f;
#pragma unroll
    for (int j = 0; j < 4; ++j) {
      float a = v[j].x - mu, b = v[j].y - mu, c = v[j].z - mu, d = v[j].w - mu;
      q += a * a + b * b + c * c + d * d;
    }
#pragma unroll
    for (int o = 32; o >= 1; o >>= 1) q += __shfl_xor(q, o);
    float rs = rsqrtf(q * (1.f / 1024.f) + 1e-5f);
    if (l == DEPTH - 1) {
#pragma unroll
      for (int j = 0; j < 4; ++j) {
        float4 o;
        o.x = (v[j].x - mu) * rs * gv[j].x + bv[j].x; o.y = (v[j].y - mu) * rs * gv[j].y + bv[j].y;
        o.z = (v[j].z - mu) * rs * gv[j].z + bv[j].z; o.w = (v[j].w - mu) * rs * gv[j].w + bv[j].w;
        *(float4*)(z + row * DM + j * 256 + lane * 4) = o;
      }
    } else {
      if (lane == 0) { stats[2 * row] = mu; stats[2 * row + 1] = rs; }
#pragma unroll
      for (int j = 0; j < 4; ++j) {
        float a = (v[j].x - mu) * rs * gv[j].x + bv[j].x, b = (v[j].y - mu) * rs * gv[j].y + bv[j].y;
        float c = (v[j].z - mu) * rs * gv[j].z + bv[j].z, d = (v[j].w - mu) * rs * gv[j].w + bv[j].w;
        uint2 pk;
        pk.x = pack2(a, b);
        pk.y = pack2(c, d);
        *(uint2*)(xb + row * DM + j * 256 + lane * 4) = pk;
      }
    }
  }
}

__device__ __forceinline__ void scan_pass(const Ctx& cx, const Params& p, int l) {
  const float* S = (const float*)(p.ws + OFF_S);
  u16* Xin = (u16*)(p.ws + OFF_CKV);
  const int lane = cx.tid & 63;
  const int gw = cx.bid * NWV + (cx.tid >> 6), nw = cx.G * NWV;
  for (int it = gw; it < NBATCH * NGRP; it += nw) {
    int b = it >> 5, g = it & 31;
    const float* at = (const float*)(p.ws + OFF_AT) + ((long)(l * NGRP + g) * 64 + lane) * 2;
    const float ar = at[0], ai = at[1];
    float xr = 0.f, xi = 0.f;
    long row0 = (long)g * NCHUNK + b * 256;
    for (int k0 = 0; k0 < 256; k0 += 32) {
      float sr[32], si[32];
#pragma unroll
      for (int j = 0; j < 32; ++j) { sr[j] = S[(row0 + k0 + j) * 128 + lane]; si[j] = S[(row0 + k0 + j) * 128 + 64 + lane]; }
#pragma unroll
      for (int j = 0; j < 32; ++j) {
        Xin[(row0 + k0 + j) * 128 + lane] = f2bf(xr);
        Xin[(row0 + k0 + j) * 128 + 64 + lane] = f2bf(xi);
        float nr = ar * xr - ai * xi + sr[j];
        float ni = ar * xi + ai * xr + si[j];
        xr = nr; xi = ni;
      }
    }
  }
}

__device__ __forceinline__ unsigned sortable(float f) {
  unsigned u = __float_as_uint(f);
  return u ^ ((unsigned)((int)u >> 31) | 0x80000000u);
}
__device__ __forceinline__ int mbcnt64(u64 m) {
  return __builtin_amdgcn_mbcnt_hi((unsigned)(m >> 32), __builtin_amdgcn_mbcnt_lo((unsigned)m, 0));
}

__device__ __forceinline__ void attn_phase(const Ctx& cx, const Params& p, char* smem) {
  const u16* qi = (const u16*)(p.ws + OFF_QI);
  const u16* ki = (const u16*)(p.ws + OFF_KI);
  const float* wi = (const float*)(p.ws + OFF_WI);
  const u16* cn = (const u16*)(p.ws + OFF_CN);
  u16* ql = (u16*)(p.ws + OFF_QL);
  const int tid = cx.tid, lane = tid & 63, wid = __builtin_amdgcn_readfirstlane(tid >> 6);
  const int hh = lane >> 5;
  const int G = cx.G;
  for (int item = cx.bid; item < (SEQL / 8) * NBATCH; item += G) {
    const int tq = (SEQL / 8 - 1) - (item >> 4), b = item & 15;
    const int t0 = tq * 8;
    const long tokbase = (long)b * SEQL;
    {
      const int r = lane & 31;
      const int qq = 2 * ((r >> 2) & 1) + (r >> 4), head = (r & 3) + 4 * ((r >> 3) & 1);
      const u16* qip = qi + (tokbase + t0 + qq) * 256 + head * 32 + 8 * hh;
      const bf16x8 qa0 = *(const bf16x8*)qip, qa1 = *(const bf16x8*)(qip + 16);
      const bf16x8 qb0 = *(const bf16x8*)(qip + 4 * 256), qb1 = *(const bf16x8*)(qip + 4 * 256 + 16);
      float w0[8], w1[8], w2[8], w3[8];
      {
        const float4* wp = (const float4*)(wi + (tokbase + t0 + 2 * hh) * 8);
        float4 a = wp[0], bq = wp[1], c = wp[2], d = wp[3];
        w0[0] = a.x; w0[1] = a.y; w0[2] = a.z; w0[3] = a.w; w0[4] = bq.x; w0[5] = bq.y; w0[6] = bq.z; w0[7] = bq.w;
        w1[0] = c.x; w1[1] = c.y; w1[2] = c.z; w1[3] = c.w; w1[4] = d.x; w1[5] = d.y; w1[6] = d.z; w1[7] = d.w;
        const float4* wq = (const float4*)(wi + (tokbase + t0 + 4 + 2 * hh) * 8);
        a = wq[0]; bq = wq[1]; c = wq[2]; d = wq[3];
        w2[0] = a.x; w2[1] = a.y; w2[2] = a.z; w2[3] = a.w; w2[4] = bq.x; w2[5] = bq.y; w2[6] = bq.z; w2[7] = bq.w;
        w3[0] = c.x; w3[1] = c.y; w3[2] = c.z; w3[3] = c.w; w3[4] = d.x; w3[5] = d.y; w3[6] = d.z; w3[7] = d.w;
      }
      const int ntiles = ((t0 + 7) >> 5) + 1;
      const int q0 = t0 + 2 * hh;
      unsigned* sc0 = (unsigned*)(smem + (2 * hh) * REG_STRIDE);
      unsigned* sc1 = (unsigned*)(smem + (2 * hh + 1) * REG_STRIDE);
      unsigned* sc2 = (unsigned*)(smem + (4 + 2 * hh) * REG_STRIDE);
      unsigned* sc3 = (unsigned*)(smem + (4 + 2 * hh + 1) * REG_STRIDE);
      bf16x8 nk0, nk1;
      {
        const u16* kp = ki + (tokbase + min(wid, ntiles - 1) * 32 + r) * 32 + 8 * hh;
        nk0 = *(const bf16x8*)kp; nk1 = *(const bf16x8*)(kp + 16);
      }
      __syncthreads();
      for (int tile = wid; tile < ntiles; tile += NWV) {
        const int key = tile * 32 + r;
        const bf16x8 kb0 = nk0, kb1 = nk1;
        {
          const u16* kp = ki + (tokbase + min(tile + NWV, ntiles - 1) * 32 + r) * 32 + 8 * hh;
          nk0 = *(const bf16x8*)kp; nk1 = *(const bf16x8*)(kp + 16);
        }
        f32x16 acc, acd;
#pragma unroll
        for (int e = 0; e < 16; ++e) { acc[e] = 0.f; acd[e] = 0.f; }
        acc = __builtin_amdgcn_mfma_f32_32x32x16_bf16(qa0, kb0, acc, 0, 0, 0);
        acd = __builtin_amdgcn_mfma_f32_32x32x16_bf16(qb0, kb0, acd, 0, 0, 0);
        acc = __builtin_amdgcn_mfma_f32_32x32x16_bf16(qa1, kb1, acc, 0, 0, 0);
        acd = __builtin_amdgcn_mfma_f32_32x32x16_bf16(qb1, kb1, acd, 0, 0, 0);
        float s0 = 0.f, s1 = 0.f, s2 = 0.f, s3 = 0.f;
#pragma unroll
        for (int e = 0; e < 8; ++e) {
          s0 += w0[e] * fmaxf(acc[e], 0.f); s1 += w1[e] * fmaxf(acc[8 + e], 0.f);
          s2 += w2[e] * fmaxf(acd[e], 0.f); s3 += w3[e] * fmaxf(acd[8 + e], 0.f);
        }
        sc0[key] = (key <= q0) ? sortable(s0) : 0u;
        sc1[key] = (key <= q0 + 1) ? sortable(s1) : 0u;
        sc2[key] = (key <= q0 + 4) ? sortable(s2) : 0u;
        sc3[key] = (key <= q0 + 5) ? sortable(s3) : 0u;
      }
      __syncthreads();
    }
    const int t = t0 + wid;
    char* reg = smem + wid * REG_STRIDE;
    const unsigned* sc = (const unsigned*)reg;
    u16* sel = (u16*)(reg + 18432);
    const int nvalid = t + 1;
    int count;
    if (nvalid <= 256) {
      count = nvalid;
      for (int i = lane; i < 256; i += 64) sel[i] = (u16)(i < nvalid ? i : 0);
    } else {
      count = 256;
      unsigned v[64];
#pragma unroll
      for (int i = 0; i < 64; ++i) { int key = i * 64 + lane; v[i] = (key < nvalid) ? sc[key] : 0u; }
      const int ni = (nvalid + 63) >> 6;
#define CNT_GE(THR, CNT) do { \
        int c_ = 0; \
        _Pragma("unroll") for (int gq = 0; gq < 4; ++gq) { \
          if (gq * 16 < ni) { \
            _Pragma("unroll") for (int j = 0; j < 16; ++j) c_ += __builtin_popcountll(__ballot(v[gq * 16 + j] >= (THR))); \
          } \
        } \
        CNT = c_; } while (0)
      unsigned vmax = 0u;
#pragma unroll
      for (int i = 0; i < 64; ++i) vmax = max(vmax, v[i]);
#pragma unroll
      for (int o = 32; o >= 1; o >>= 1) vmax = max(vmax, (unsigned)__shfl_xor((int)vmax, o));
      vmax = (unsigned)__builtin_amdgcn_readfirstlane((int)vmax);
      unsigned lo = 0u, hi = vmax + 1u;
      int clo = 4096, chi = 0;
      bool positive = false;
      {
        int c0; CNT_GE(0x80000000u, c0);
        if (c0 >= 256) { lo = 0x80000000u; clo = c0; positive = true; }
        else { hi = 0x80000000u; chi = c0; }
      }
      while (clo != 256 && clo - chi > 128 && hi - lo > 1u) {
        unsigned mid = lo + ((hi - lo) >> 1);
        if (positive) {
          const float fm = 0.5f * (__uint_as_float(lo & 0x7fffffffu) + __uint_as_float(hi & 0x7fffffffu));
          const unsigned m2 = __float_as_uint(fm) | 0x80000000u;
          if (m2 > lo && m2 < hi) mid = m2;
        }
        int cnt; CNT_GE(mid, cnt);
        if (cnt >= 256) { lo = mid; clo = cnt; } else { hi = mid; chi = cnt; }
      }
      if (clo <= 384) {
        unsigned* dval = (unsigned*)(reg + 8192);
        u16* dkey = (u16*)(reg + 8192 + 1536);
        {
          int base = 0;
#pragma unroll
          for (int gq = 0; gq < 4; ++gq) {
            if (gq * 16 < ni) {
#pragma unroll
              for (int j = 0; j < 16; ++j) {
                const int i = gq * 16 + j;
                const bool in = v[i] >= lo;
                const u64 m = __ballot(in);
                if (in) { const int pos = base + mbcnt64(m); dval[pos] = v[i]; dkey[pos] = (u16)(i * 64 + lane); }
                base += __builtin_popcountll(m);
              }
            }
          }
        }
        unsigned dv[6]; int dk[6];
#pragma unroll
        for (int j = 0; j < 6; ++j) {
          const int idx = j * 64 + lane;
          dv[j] = (idx < clo) ? dval[idx] : 0u;
          dk[j] = (idx < clo) ? (int)dkey[idx] : 0;
        }
        while (clo != 256 && hi - lo > 1u) {
          const unsigned mid = lo + ((hi - lo) >> 1);
          int cnt = 0;
#pragma unroll
          for (int j = 0; j < 6; ++j) cnt += __builtin_popcountll(__ballot(dv[j] >= mid));
          if (cnt >= 256) { lo = mid; clo = cnt; } else { hi = mid; chi = cnt; }
        }
        int base = 0, eqleft = (clo == 256) ? 512 : 256 - chi;
#pragma unroll
        for (int j = 0; j < 6; ++j) {
          const bool gt = dv[j] > lo, eq = dv[j] == lo;
          const u64 meq = __ballot(eq);
          const bool take = gt || (eq && mbcnt64(meq) < eqleft);
          const u64 mt = __ballot(take);
          if (take) sel[base + mbcnt64(mt)] = (u16)dk[j];
          base += __builtin_popcountll(mt);
          eqleft -= min((int)__builtin_popcountll(meq), eqleft);
        }
      } else {
        int base = 0, eqleft = 256 - chi;
#pragma unroll
        for (int gq = 0; gq < 4; ++gq) {
          if (gq * 16 < ni) {
#pragma unroll
            for (int j = 0; j < 16; ++j) {
              const int i = gq * 16 + j;
              const bool gt = v[i] > lo, eq = v[i] == lo;
              const u64 meq = __ballot(eq);
              const bool take = gt || (eq && mbcnt64(meq) < eqleft);
              const u64 mt = __ballot(take);
              if (take) sel[base + mbcnt64(mt)] = (u16)(i * 64 + lane);
              base += __builtin_popcountll(mt);
              eqleft -= min((int)__builtin_popcountll(meq), eqleft);
              if ((j & 3) == 3) __builtin_amdgcn_sched_barrier(0);
            }
          }
        }
      }
    }
    {
      const long token = tokbase + t;
      const int hd = lane & 15, g4 = lane >> 4;
      bf16x8 qf[4];
#pragma unroll
      for (int ks = 0; ks < 4; ++ks) {
        if (hd < 8) qf[ks] = *(const bf16x8*)(ql + token * 1024 + hd * 128 + 32 * ks + 8 * g4);
        else { for (int e = 0; e < 8; ++e) qf[ks][e] = 0; }
      }
      const int nch = (count + 31) >> 5;
      f32x4 o[8];
#pragma unroll
      for (int c = 0; c < 8; ++c) o[c] = (f32x4){0.f, 0.f, 0.f, 0.f};
      float mrun = -1e30f, lsum = 0.f;
      const int qd = (lane & 15) >> 2, pq = lane & 3;
      bf16x8 kr[8];
#define LOADK32(JJ) do { \
        _Pragma("unroll") for (int j = 0; j < 8; ++j) { \
          const int key_ = sel[32 * (JJ) + 4 * j + g4]; \
          kr[j] = *(const bf16x8*)(cn + (tokbase + key_) * 128 + 8 * hd); \
        } } while (0)
      LOADK32(0);
      for (int jj = 0; jj < nch; ++jj) {
#pragma unroll
        for (int j = 0; j < 8; ++j) *(bf16x8*)(reg + (4 * j + g4) * KROW + hd * 16) = kr[j];
        __builtin_amdgcn_sched_barrier(0);
        if (jj + 1 < nch) LOADK32(jj + 1);
        __builtin_amdgcn_sched_barrier(0);
        f32x4 sacc[2];
#pragma unroll
        for (int tt = 0; tt < 2; ++tt) {
          sacc[tt] = (f32x4){0.f, 0.f, 0.f, 0.f};
#pragma unroll
          for (int ks = 0; ks < 4; ++ks) {
            const bf16x8 kfr = *(const bf16x8*)(reg + (16 * tt + hd) * KROW + (32 * ks + 8 * g4) * 2);
            sacc[tt] = __builtin_amdgcn_mfma_f32_16x16x32_bf16(kfr, qf[ks], sacc[tt], 0, 0, 0);
          }
        }
        if (32 * jj + 32 > count) {
#pragma unroll
          for (int tt = 0; tt < 2; ++tt)
#pragma unroll
            for (int i = 0; i < 4; ++i) {
              const int slot = 32 * jj + 16 * tt + 4 * g4 + i;
              if (slot >= count) sacc[tt][i] = -1e30f;
            }
        }
        float mloc = fmaxf(fmaxf(fmaxf(sacc[0][0], sacc[0][1]), fmaxf(sacc[0][2], sacc[0][3])),
                           fmaxf(fmaxf(sacc[1][0], sacc[1][1]), fmaxf(sacc[1][2], sacc[1][3])));
        mloc = fmaxf(mloc, __shfl_xor(mloc, 16));
        mloc = fmaxf(mloc, __shfl_xor(mloc, 32));
        const float mnew = fmaxf(mrun, mloc);
        const float alpha = __builtin_amdgcn_exp2f(mrun - mnew);
        mrun = mnew;
        float pv[8];
#pragma unroll
        for (int tt = 0; tt < 2; ++tt)
#pragma unroll
          for (int i = 0; i < 4; ++i) pv[tt * 4 + i] = __builtin_amdgcn_exp2f(sacc[tt][i] - mnew);
        const float ps = ((pv[0] + pv[1]) + (pv[2] + pv[3])) + ((pv[4] + pv[5]) + (pv[6] + pv[7]));
        bf16x8 pb;
        {
          unsigned* pw = (unsigned*)&pb;
          pw[0] = pack2(pv[0], pv[1]); pw[1] = pack2(pv[2], pv[3]); pw[2] = pack2(pv[4], pv[5]); pw[3] = pack2(pv[6], pv[7]);
        }
        lsum = lsum * alpha + ps;
#pragma unroll
        for (int c = 0; c < 8; ++c) { o[c][0] *= alpha; o[c][1] *= alpha; o[c][2] *= alpha; o[c][3] *= alpha; }
#pragma unroll
        for (int c = 0; c < 8; ++c) {
          const unsigned a_lo = (unsigned)(size_t)(reg) ;
          (void)a_lo;
          s16x4 lo = __builtin_amdgcn_ds_read_tr16_b64_v4i16(
              (s16x4 __attribute__((address_space(3)))*)(reg + (4 * g4 + qd) * KROW + (16 * c + 4 * pq) * 2));
          s16x4 hi = __builtin_amdgcn_ds_read_tr16_b64_v4i16(
              (s16x4 __attribute__((address_space(3)))*)(reg + (16 + 4 * g4 + qd) * KROW + (16 * c + 4 * pq) * 2));
          bf16x8 vf;
          vf[0] = lo[0]; vf[1] = lo[1]; vf[2] = lo[2]; vf[3] = lo[3];
          vf[4] = hi[0]; vf[5] = hi[1]; vf[6] = hi[2]; vf[7] = hi[3];
          o[c] = __builtin_amdgcn_mfma_f32_16x16x32_bf16(vf, pb, o[c], 0, 0, 0);
        }
      }
      lsum += __shfl_xor(lsum, 16);
      lsum += __shfl_xor(lsum, 32);
      const float inv = 1.f / lsum;
      if (hd < 8) {
#pragma unroll
        for (int c = 0; c < 8; ++c) {
          uint2 pk;
          pk.x = pack2(o[c][0] * inv, o[c][1] * inv);
          pk.y = pack2(o[c][2] * inv, o[c][3] * inv);
          *(uint2*)(ql + token * 1024 + hd * 128 + 16 * c + 4 * g4) = pk;
        }
      }
    }
  }
}

__device__ __forceinline__ void run_epilogue(const Params& p, int l, int epi, int b, int row0, int col0, int tid, const float* sC, int ncols) {
  char* ws = p.ws;
  switch (epi) {
    case 0: { EpiInProj e{(u16*)(ws + OFF_QB), (u16*)(ws + OFF_QI), (u16*)(ws + OFF_KI), (u16*)(ws + OFF_SGA), (u16*)(ws + OFF_SGS),
                          (u16*)(ws + OFF_UGM), (u16*)(ws + OFF_CN), (float*)(ws + OFF_WI), p.kvg + l * 128};
              e.run(b, row0, col0, tid, sC, ncols); } break;
    case 1: { EpiQlat e{(u16*)(ws + OFF_QL)}; e.run(b, row0, col0, tid, sC, ncols); } break;
    case 2: { EpiS e{(float*)(ws + OFF_S)}; e.run(b, row0, col0, tid, sC, ncols); } break;
    case 3: { EpiUv e{(const u16*)(ws + OFF_SGA), (u16*)(ws + OFF_XB)}; e.run(b, row0, col0, tid, sC, ncols); } break;
    case 4: { EpiY e{(const u16*)(ws + OFF_UGM), p.d_skip + l * 512, (u16*)(ws + OFF_QB)}; e.run(b, row0, col0, tid, sC, ncols); } break;
    case 5: { EpiGlu e{(const u16*)(ws + OFF_SGS), p.b_glu + l * 1024, (u16*)(ws + OFF_XB)}; e.run(b, row0, col0, tid, sC, ncols); } break;
    default: { EpiOut e{p.x, p.out, (const float*)(ws + OFF_STATS), p.ln_g + (l > 0 ? l - 1 : 0) * DM, p.ln_b + (l > 0 ? l - 1 : 0) * DM, l == 0 ? 1 : 0};
               e.run(b, row0, col0, tid, sC, ncols); } break;
  }
}

__device__ __forceinline__ void make_desc(GemmDesc& d, const Params& p, int l, int op) {
  char* ws = p.ws;
  d.A2 = nullptr; d.a2_bs = 0; d.lda2 = 0; d.ksplit = 1 << 30;
  switch (op) {
    case 0:
      d.A = (const u16*)(ws + OFF_XB); d.lda = DM; d.a_bs = 0;
      d.Bt = (const u16*)(ws + OFF_WINT) + (long)l * NPAD * DM; d.ldb = DM; d.b_bs = 0;
      d.M = NTOK; d.N = NPAD; d.K = DM; d.nbatch = 1; break;
    case 1:
      d.A = (const u16*)(ws + OFF_QB); d.lda = 512; d.a_bs = 64;
      d.Bt = (const u16*)(ws + OFF_WUK) + (long)l * 8 * 128 * 64; d.ldb = 64; d.b_bs = 128 * 64;
      d.M = NTOK; d.N = 128; d.K = 64; d.nbatch = 8; break;
    case 2:
      d.A = (const u16*)(ws + OFF_UGM); d.lda = 256; d.a_bs = (long)NTOK * 16;
      d.Bt = (const u16*)(ws + OFF_OP1) + (long)l * NGRP * 128 * 256; d.ldb = 256; d.b_bs = 128 * 256;
      d.M = NCHUNK; d.N = 128; d.K = 256; d.nbatch = NGRP; break;
    case 3:
      d.A = (const u16*)(ws + OFF_QL); d.lda = 1024; d.a_bs = 256;
      d.Bt = (const u16*)(ws + OFF_WUVP) + (long)l * 4 * 128 * 256; d.ldb = 256; d.b_bs = 128 * 256;
      d.M = NTOK; d.N = 128; d.K = 256; d.nbatch = 4; break;
    case 4:
      d.A = (const u16*)(ws + OFF_UGM); d.lda = 256; d.a_bs = (long)NTOK * 16;
      d.A2 = (const u16*)(ws + OFF_CKV); d.lda2 = 128; d.a2_bs = (long)NCHUNK * 128; d.ksplit = 256;
      d.Bt = (const u16*)(ws + OFF_OP2) + (long)l * NGRP * 256 * 384; d.ldb = 384; d.b_bs = 256 * 384;
      d.M = NCHUNK; d.N = 256; d.K = 384; d.nbatch = NGRP; break;
    case 5:
      d.A = (const u16*)(ws + OFF_QB); d.lda = 512; d.a_bs = 0;
      d.Bt = (const u16*)(ws + OFF_WGLUT) + (long)l * 1024 * 512; d.ldb = 512; d.b_bs = 0;
      d.M = NTOK; d.N = 1024; d.K = 512; d.nbatch = 1; break;
    default:
      d.A = (const u16*)(ws + OFF_XB); d.lda = DM; d.a_bs = 0;
      d.Bt = (const u16*)(ws + OFF_WOUTT) + (long)l * DM * DM; d.ldb = DM; d.b_bs = 0;
      d.M = NTOK; d.N = DM; d.K = DM; d.nbatch = 1; break;
  }
}

__device__ __forceinline__ void run_phase(const Params& p, int ph, int wid0, char* smem) {
  Ctx cx; cx.bid = blockIdx.x; cx.G = gridDim.x;
  {
    int wid_s = wid0; OPAQUE_S(wid_s);
    cx.tid = wid_s * 64 + (int)__builtin_amdgcn_mbcnt_hi(~0u, __builtin_amdgcn_mbcnt_lo(~0u, 0u));
  }
  OPAQUE_V(cx.tid); OPAQUE_S(cx.bid); OPAQUE_S(cx.G);
  if (ph == 0) { prologue_phase(cx, p, smem); return; }
  const int l = (ph - 1) / 7, s = (ph - 1) % 7;
  int op0 = -1, nops = 0;
  if (s == 0) { op0 = 0; nops = 1; }
  else if (s == 1) { op0 = 1; nops = 2; }
  else if (s == 3) { op0 = 3; nops = 2; }
  else if (s == 4) { op0 = 5; nops = 1; }
  else if (s == 5) { op0 = 6; nops = 1; }
  for (int i = 0; i < nops; ++i) {
    GemmDesc d;
    make_desc(d, p, l, op0 + i);
    gemm_phase(cx, d, op0 + i, p, l, smem);
  }

  if (s == 2) { scan_pass(cx, p, l); attn_phase(cx, p, smem); }
  if (s == 6) layernorm_pass(cx, p, l);
}

__global__ void __launch_bounds__(NTHR, 2) hymba_megakernel(Params p) {
  __shared__ __attribute__((aligned(16))) char smem[SMEM_BYTES];
  cg::grid_group grid = cg::this_grid();
  const int wid0 = __builtin_amdgcn_readfirstlane((int)(threadIdx.x >> 6));
  for (int ph = p.phase_lo; ph < p.phase_hi; ++ph) {
    run_phase(p, ph, wid0, smem);
    if (ph + 1 < p.phase_hi) grid.sync();
  }
}

#ifndef MULTI_LAUNCH
#define MULTI_LAUNCH 0
#endif

extern "C" void kernel_launch(void* const* d_in, const int* in_sizes, int n_in, void* d_out, int out_size, void* d_ws, size_t ws_size,
                              hipStream_t stream) {
  static int grid_blocks = 0;
  if (!grid_blocks) {
    int dev = 0, cus = 0, per_cu = 0;
    hipGetDevice(&dev);
    hipDeviceGetAttribute(&cus, hipDeviceAttributeMultiprocessorCount, dev);
    hipOccupancyMaxActiveBlocksPerMultiprocessor(&per_cu, hymba_megakernel, NTHR, 0);
    if (per_cu > 1) per_cu = 1;
    if (per_cu < 1) per_cu = 1;
    grid_blocks = cus * per_cu;
  }
  Params p{};
  p.x = (const float*)d_in[0]; p.w_in = (const float*)d_in[1]; p.kvg = (const float*)d_in[2]; p.w_uk = (const float*)d_in[3];
  p.w_uv = (const float*)d_in[4]; p.log_dt = (const float*)d_in[5]; p.a_re = (const float*)d_in[6]; p.a_im = (const float*)d_in[7];
  p.b_re = (const float*)d_in[8]; p.b_im = (const float*)d_in[9]; p.c_re = (const float*)d_in[10]; p.c_im = (const float*)d_in[11];
  p.d_skip = (const float*)d_in[12]; p.w_glu = (const float*)d_in[13]; p.b_glu = (const float*)d_in[14]; p.w_out = (const float*)d_in[15];
  p.ln_g = (const float*)d_in[16]; p.ln_b = (const float*)d_in[17];
  p.out = (float*)d_out; p.ws = (char*)d_ws;
  const int nph = 1 + 7 * DEPTH;
#if MULTI_LAUNCH
  for (int ph = 0; ph < nph; ++ph) {
    p.phase_lo = ph; p.phase_hi = ph + 1;
    hipLaunchKernelGGL(hymba_megakernel, dim3(grid_blocks), dim3(NTHR), 0, stream, p);
  }
#else
  p.phase_lo = 0; p.phase_hi = nph;
  void* args[] = {&p};
  hipError_t e = hipLaunchCooperativeKernel((void*)hymba_megakernel, dim3(grid_blocks), dim3(NTHR), args, 0, stream);
  if (e != hipSuccess) fprintf(stderr, "cooperative launch failed: %s (grid %d)\n", hipGetErrorString(e), grid_blocks);
#endif
}
```
